# Optimizing an MI355X kernel written in HIP

```python
import jax, jax.numpy as jnp
from jax import lax
import numpy as np

D_MODEL = 2048
BATCH = 4
SEQ = 8192
DEPTH = 1

HEAD_DIM = 64
N_HEADS_A = D_MODEL // (2 * HEAD_DIM)
N_KV_A = N_HEADS_A // 8
N_HEADS_B = D_MODEL // (2 * HEAD_DIM)
WINDOW_A = 128
DILATED_BRANCHES = ((128, 1), (512, 4), (2048, 16))
D_FF = 4 * D_MODEL
BLOCK = 128
EPS = 1e-5
NEG_INF = -1e30

Q_A = N_HEADS_A * HEAD_DIM
KV_A = N_KV_A * HEAD_DIM
Q_B = N_HEADS_B * HEAD_DIM
D_IN = Q_A + 2 * KV_A + 3 * Q_B
D_MIX = Q_A + Q_B

kernel_name = "hybrid_swa_sink_dilated_alibi_block"


def alibi_slopes(n):
    return jnp.asarray(2.0 ** (-8.0 * (np.arange(n) + 1) / n), dtype=jnp.float32)


def rmsnorm(x, g):
    x32 = x.astype(jnp.float32)
    y = x32 * lax.rsqrt(jnp.mean(x32 * x32, axis=-1, keepdims=True) + EPS)
    return y.astype(x.dtype) * g


def _with_prev_block(t, nb):
    b, L, G, Dh = t.shape
    tb = t.reshape(b, nb, BLOCK, G, Dh)
    prev = jnp.concatenate([jnp.zeros_like(tb[:, :1]), tb[:, :-1]], axis=1)
    return jnp.concatenate([prev, tb], axis=2)


def banded_attention(q, k, v, max_steps, step_dist, slopes, sinks):
    b, L, H, Dh = q.shape
    G = k.shape[2]
    R = H // G
    nb = L // BLOCK
    qb = q.reshape(b, nb, BLOCK, G, R, Dh)
    kb = _with_prev_block(k, nb)
    vb = _with_prev_block(v, nb)
    s = jnp.einsum('bnqgrd,bnkgd->bngrqk', qb, kb).astype(jnp.float32) * (Dh ** -0.5)
    qi = jnp.arange(BLOCK)[:, None]
    kj = jnp.arange(2 * BLOCK)[None, :]
    steps = qi + BLOCK - kj
    kpos = jnp.arange(nb)[:, None, None] * BLOCK + kj[None] - BLOCK
    valid = (steps >= 0) & (steps <= max_steps) & (kpos >= 0)
    alibi = slopes.reshape(G, R, 1, 1) * (step_dist * steps).astype(jnp.float32)
    s = jnp.where(valid[None, :, None, None], s - alibi[None, None], NEG_INF)
    m = jnp.max(s, axis=-1)
    if sinks is not None:
        sink = sinks.astype(jnp.float32).reshape(G, R, 1)
        m = jnp.maximum(m, sink)
    p = jnp.exp(s - m[..., None])
    denom = jnp.sum(p, axis=-1)
    if sinks is not None:
        denom = denom + jnp.exp(sink - m)
    o = jnp.einsum('bngrqk,bnkgd->bnqgrd', p, vb.astype(jnp.float32))
    o = o / jnp.moveaxis(denom, -1, 2)[..., None]
    lse = jnp.moveaxis(m + jnp.log(denom), -1, 2)
    return o.reshape(b, L, H, Dh), lse.reshape(b, L, H)


def _strided(t, dil, Lp):
    b, S, H, Dh = t.shape
    L = S // dil
    t = t.reshape(b, L, dil, H, Dh).transpose(0, 2, 1, 3, 4).reshape(b * dil, L, H, Dh)
    return jnp.pad(t, ((0, 0), (0, Lp - L), (0, 0), (0, 0)))


def dilated_mixture(q, k, v, slopes):
    b, S, H, Dh = q.shape
    outs, lses = [], []
    for window, dil in DILATED_BRANCHES:
        L = S // dil
        Lp = -(-L // BLOCK) * BLOCK
        o, lse = banded_attention(_strided(q, dil, Lp), _strided(k, dil, Lp),
                                  _strided(v, dil, Lp), window // dil, dil, slopes, None)
        outs.append(o[:, :L].reshape(b, dil, L, H, Dh).transpose(0, 2, 1, 3, 4).reshape(b, S, H, Dh))
        lses.append(lse[:, :L].reshape(b, dil, L, H).transpose(0, 2, 1, 3).reshape(b, S, H))
    w = jax.nn.softmax(jnp.stack(lses), axis=0)
    return jnp.einsum('nbsh,nbshd->bshd', w, jnp.stack(outs)).astype(q.dtype)


def setup_inputs(seed: int = 0) -> dict:
    key = jax.random.key(seed)
    ks = jax.random.split(key, 12)
    f32 = jnp.float32
    x = jax.random.normal(ks[0], (BATCH, SEQ, D_MODEL), f32)
    g_attn = 1.0 + 0.02 * jax.random.normal(ks[1], (DEPTH, D_MODEL), f32)
    w_in = jax.random.normal(ks[2], (DEPTH, D_MODEL, D_IN), f32) * D_MODEL ** -0.5
    b_in = 0.02 * jax.random.normal(ks[3], (DEPTH, D_IN), f32)
    sinks_a = jax.random.normal(ks[4], (DEPTH, N_HEADS_A), f32)
    g_out_a = 1.0 + 0.02 * jax.random.normal(ks[5], (DEPTH, Q_A), f32)
    g_out_b = 1.0 + 0.02 * jax.random.normal(ks[6], (DEPTH, Q_B), f32)
    w_out = jax.random.normal(ks[7], (DEPTH, D_MIX, D_MODEL), f32) * D_MIX ** -0.5
    g_mlp = 1.0 + 0.02 * jax.random.normal(ks[8], (DEPTH, D_MODEL), f32)
    w_1 = jax.random.normal(ks[9], (DEPTH, D_MODEL, D_FF), f32) * D_MODEL ** -0.5
    w_2 = jax.random.normal(ks[10], (DEPTH, D_FF, D_MODEL), f32) * D_FF ** -0.5
    g_final = 1.0 + 0.02 * jax.random.normal(ks[11], (D_MODEL,), f32)
    return {"x": x, "g_attn": g_attn, "w_in": w_in, "b_in": b_in, "sinks_a": sinks_a,
            "g_out_a": g_out_a, "g_out_b": g_out_b, "w_out": w_out, "g_mlp": g_mlp,
            "w_1": w_1, "w_2": w_2, "g_final": g_final}


def reference(x, g_attn, w_in, b_in, sinks_a, g_out_a, g_out_b, w_out, g_mlp, w_1, w_2, g_final):
    b, S, _ = x.shape
    slopes_a = alibi_slopes(N_HEADS_A)
    slopes_b = alibi_slopes(N_HEADS_B)
    for l in range(DEPTH):
        h = rmsnorm(x, g_attn[l])
        proj = jnp.einsum('bsd,de->bse', h, w_in[l]) + b_in[l]
        o1 = Q_A
        o2 = o1 + KV_A
        o3 = o2 + KV_A
        o4 = o3 + Q_B
        o5 = o4 + Q_B
        qa = proj[..., :o1].reshape(b, S, N_HEADS_A, HEAD_DIM)
        ka = proj[..., o1:o2].reshape(b, S, N_KV_A, HEAD_DIM)
        va = proj[..., o2:o3].reshape(b, S, N_KV_A, HEAD_DIM)
        qb = proj[..., o3:o4].reshape(b, S, N_HEADS_B, HEAD_DIM)
        kb = proj[..., o4:o5].reshape(b, S, N_HEADS_B, HEAD_DIM)
        vb = proj[..., o5:].reshape(b, S, N_HEADS_B, HEAD_DIM)
        oa, _ = banded_attention(qa, ka, va, WINDOW_A - 1, 1, slopes_a, sinks_a[l])
        ya = rmsnorm(oa.astype(x.dtype).reshape(b, S, Q_A), g_out_a[l])
        ob = dilated_mixture(qb, kb, vb, slopes_b)
        yb = rmsnorm(ob.reshape(b, S, Q_B), g_out_b[l])
        mix = jnp.concatenate([ya, yb], axis=-1)
        x = x + jnp.einsum('bse,ed->bsd', mix, w_out[l])
        h = rmsnorm(x, g_mlp[l])
        u = jax.nn.relu(jnp.einsum('bsd,df->bsf', h, w_1[l]))
        x = x + jnp.einsum('bsf,fd->bsd', u * u, w_2[l])
    return rmsnorm(x, g_final)
```

```cpp
#include <hip/hip_runtime.h>
#include <hip/hip_bf16.h>
#include <cstdio>
#include <cstdint>

#ifndef MK_N_LAUNCHES
#define MK_N_LAUNCHES 9
#endif

constexpr int BATCH = 4, SEQ = 8192, DM = 2048, DIN = 4352, FF = 8192, NH = 16, HD = 64;
constexpr int MROWS = BATCH * SEQ;
constexpr int QA_OFF = 0, KA_OFF = 1024, VA_OFF = 1152, QB_OFF = 1280, KB_OFF = 2304, VB_OFF = 3328;
constexpr float RMS_EPS = 1e-5f;
constexpr float LOG2E = 1.4426950408889634f;
constexpr float QSCALE = 0.125f * LOG2E;

namespace pg8 {
#define PG8_LAS __attribute__((address_space(3)))
typedef unsigned short bf16_t;
typedef short bf16x8 __attribute__((ext_vector_type(8)));
typedef float f32x4 __attribute__((ext_vector_type(4)));
typedef unsigned u32x4 __attribute__((ext_vector_type(4)));
constexpr int BM = 256, BK = 64, HALF = 128, HTB = HALF * BK * 2  , STAGE_BYTES = 8 * HTB, NXCD = 8, WGM = 8;

__host__ __device__ __forceinline__ int lds_byte(int r, int c) { const int st = (r >> 4) * 2 + (c >> 5), rr = r & 15, cc = c & 31, ob = rr * 64 + cc * 2; return st * 1024 + (ob ^ (((ob >> 9) & 1) << 5)); }
__host__ __device__ __forceinline__ void stage_rc(int b, int& R, int& C) { const int st = b / 1024, sb = b % 1024, swz = sb ^ (((sb >> 9) & 1) << 5); R = (st >> 1) * 16 + swz / 64; C = (st & 1) * 32 + (swz % 64) / 2; }
__host__ __device__ __forceinline__ int perm32(int rho) { const int n = rho >> 4, i = rho & 15; return 8 * (i >> 2) + 4 * n + (i & 3); }

struct Unit { int pm, pn; };
struct Gemm { const bf16_t* A; const bf16_t* Bt; int M, N, K; };

struct StaticOrder {
    int nM, nN, nwg, G, c;
    __host__ __device__ void init(int M, int N, int G_, int c_) { nM = M / BM; nN = N / BM; nwg = nM * nN; G = G_; c = c_; }
    __host__ __device__ bool next(int i, Unit& u) const {
        const long L = (long)i * G + c; if (L >= nwg) return false;
        int wgid = (int)L; { const int q = nwg / NXCD, r = nwg % NXCD, xcd = wgid % NXCD, off = wgid / NXCD; wgid = (xcd < r ? xcd * (q + 1) : r * (q + 1) + (xcd - r) * q) + off; }
        const int nig = WGM * nN, gid = wgid / nig, fm = gid * WGM, gsz = (nM - fm) < WGM ? (nM - fm) : WGM;
        u.pm = fm + ((wgid % nig) % gsz); u.pn = (wgid % nig) / gsz; return true;
    }
    __device__ __forceinline__ void a_ready(const Unit&) const {}
    __device__ __forceinline__ void done(const Unit&) const {}
};

__device__ __forceinline__ unsigned cvt_pk_bf16(float lo, float hi) { unsigned r; asm volatile("v_cvt_pk_bf16_f32 %0, %1, %2" : "=v"(r) : "v"(lo), "v"(hi)); return r; }

struct EpiProj {
    static constexpr bool PERM = true, AFTER_DRAIN = false;
    bf16_t* O; int ldc; const float* bias; float qscale;
    __device__ __forceinline__ void operator()(const f32x4 (&acc)[2][2][4][2], const Unit& u, int wr, int wc, int fr, int fq) const {
        const int row0 = u.pm * BM + wr * 64 + fr;
        const float sc = (u.pn < 4 || (u.pn >= 5 && u.pn < 9)) ? qscale : 1.f;
        const int col0 = u.pn * BM + wc * 32 + 8 * fq;
        f32x4 bv[2][2];
#pragma unroll
        for (int bj = 0; bj < 2; ++bj)
#pragma unroll
            for (int n = 0; n < 2; ++n) bv[bj][n] = *(const f32x4*)(bias + col0 + bj * HALF + 4 * n);
#pragma unroll
        for (int ai = 0; ai < 2; ++ai)
#pragma unroll
            for (int m = 0; m < 4; ++m) { bf16_t* rowp = O + (size_t)(row0 + ai * HALF + m * 16) * ldc + col0;
#pragma unroll
                for (int bj = 0; bj < 2; ++bj) { f32x4 v0 = (acc[ai][bj][m][0] + bv[bj][0]) * sc, v1 = (acc[ai][bj][m][1] + bv[bj][1]) * sc;
                    u32x4 w; w.x = cvt_pk_bf16(v0[0], v0[1]); w.y = cvt_pk_bf16(v0[2], v0[3]); w.z = cvt_pk_bf16(v1[0], v1[1]); w.w = cvt_pk_bf16(v1[2], v1[3]);
                    *(u32x4*)(rowp + bj * HALF) = w; } }
    }
};
struct EpiRelu2 {
    static constexpr bool PERM = true, AFTER_DRAIN = false;
    bf16_t* O; int ldc;
    __device__ __forceinline__ void operator()(const f32x4 (&acc)[2][2][4][2], const Unit& u, int wr, int wc, int fr, int fq) const {
        const int row0 = u.pm * BM + wr * 64 + fr;
        const int col0 = u.pn * BM + wc * 32 + 8 * fq;
#pragma unroll
        for (int ai = 0; ai < 2; ++ai)
#pragma unroll
            for (int m = 0; m < 4; ++m) { bf16_t* rowp = O + (size_t)(row0 + ai * HALF + m * 16) * ldc + col0;
#pragma unroll
                for (int bj = 0; bj < 2; ++bj) { f32x4 v0 = acc[ai][bj][m][0], v1 = acc[ai][bj][m][1];
#pragma unroll
                    for (int e = 0; e < 4; ++e) { const float a = fmaxf(v0[e], 0.f), b = fmaxf(v1[e], 0.f); v0[e] = a * a; v1[e] = b * b; }
                    u32x4 w; w.x = cvt_pk_bf16(v0[0], v0[1]); w.y = cvt_pk_bf16(v0[2], v0[3]); w.z = cvt_pk_bf16(v1[0], v1[1]); w.w = cvt_pk_bf16(v1[2], v1[3]);
                    *(u32x4*)(rowp + bj * HALF) = w; } }
    }
};
struct EpiResF32 {
    static constexpr bool PERM = false, AFTER_DRAIN = false;
    const float* base; float* out; int ldc;
    __device__ __forceinline__ void operator()(const f32x4 (&acc)[2][2][4][2], const Unit& u, int wr, int wc, int fr, int fq) const {
        const int row0 = u.pm * BM + wr * 64 + fr, col0 = u.pn * BM + wc * 32 + 4 * fq;
#pragma unroll
        for (int ai = 0; ai < 2; ++ai)
#pragma unroll
            for (int m = 0; m < 4; ++m) { const size_t off = (size_t)(row0 + ai * HALF + m * 16) * ldc + col0;
                f32x4 bs[2][2];
#pragma unroll
                for (int bj = 0; bj < 2; ++bj)
#pragma unroll
                    for (int n = 0; n < 2; ++n) bs[bj][n] = *(const f32x4*)(base + off + bj * HALF + n * 16);
#pragma unroll
                for (int bj = 0; bj < 2; ++bj)
#pragma unroll
                    for (int n = 0; n < 2; ++n) *(f32x4*)(out + off + bj * HALF + n * 16) = bs[bj][n] + acc[ai][bj][m][n];
                if (m & 1) asm volatile("" ::: "memory"); }
    }
};

template <class Epi, class Sched, bool ALIGN_EPI = false, bool SP2 = false>
__device__ __forceinline__ void gemm_phase(PG8_LAS unsigned char* lds, const Gemm g, const Sched& S, const Epi& E) {
    const int tid = threadIdx.x, wid = __builtin_amdgcn_readfirstlane(tid >> 6), lane = tid & 63, wr = wid >> 2, wc = wid & 3, fr = lane & 15, fq = lane >> 4;
    const int K = g.K, nt = K / BK;
    unsigned voffA[2], voffB[2];
#pragma unroll
    for (int i = 0; i < 2; ++i) { int R, C; stage_rc(tid * 16 + i * 8192, R, C); const int Rb = Epi::PERM ? ((R & ~31) + perm32(R & 31)) : R;
        voffA[i] = (unsigned)(R * K + C) * 2u; voffB[i] = (unsigned)(Rb * K + C) * 2u; }
    const size_t kstep = (size_t)(BK * 2);
    const size_t hstep = (size_t)HALF * K * 2;
    const size_t tstep = 2 * hstep;
    const unsigned ldsw = (unsigned)wid * 1024u;
    const int aoff = lds_byte(wr * 64 + fr, fq * 8), boff = lds_byte(wc * 32 + fr, fq * 8);
#define PG8_SA(b, h) (((b) * 2 + (h)) * HTB)
#define PG8_SB(b, h) ((4 + (b) * 2 + (h)) * HTB)
#define PG8_STAGE(bufoff, gbase, voff) do { _Pragma("unroll") for (int _i = 0; _i < 2; ++_i) \
        __builtin_amdgcn_global_load_lds((const unsigned*)((const char*)(gbase) + (voff)[_i]), (PG8_LAS unsigned*)(lds + (bufoff) + ldsw + _i * 8192), 16, 0, 0); } while (0)
#define PG8_LDA(dst, b, h) do { _Pragma("unroll") for (int m = 0; m < 4; ++m) _Pragma("unroll") for (int k = 0; k < 2; ++k) dst[m][k] = *(const PG8_LAS bf16x8*)(lds + PG8_SA(b, h) + aoff + m * 2048 + k * 1024); } while (0)
#define PG8_LDB(dst, b, h) do { _Pragma("unroll") for (int n = 0; n < 2; ++n) _Pragma("unroll") for (int k = 0; k < 2; ++k) dst[n][k] = *(const PG8_LAS bf16x8*)(lds + PG8_SB(b, h) + boff + n * 2048 + k * 1024); } while (0)
#define PG8_MMA(ai, bj, At, Bt) do { __builtin_amdgcn_s_setprio(1); _Pragma("unroll") for (int m = 0; m < 4; ++m) _Pragma("unroll") for (int n = 0; n < 2; ++n) _Pragma("unroll") for (int k = 0; k < 2; ++k) \
        acc[ai][bj][m][n] = __builtin_amdgcn_mfma_f32_16x16x32_bf16(Bt[n][k], At[m][k], acc[ai][bj][m][n], 0, 0, 0); __builtin_amdgcn_s_setprio(0); } while (0)
#define PG8_WAIT_V(n) asm volatile("s_waitcnt vmcnt(" #n ")" ::: "memory")
#define PG8_WAIT_L(n) asm volatile("s_waitcnt lgkmcnt(" #n ")" ::: "memory")
#define PG8_BAR __builtin_amdgcn_s_barrier()
#define PG8_SCHED __builtin_amdgcn_sched_barrier(0)
    Unit cur, nxt; int ui = 0;
    if (!S.next(0, cur)) return;
    f32x4 acc[2][2][4][2];
#pragma unroll
    for (int a = 0; a < 2; ++a)
#pragma unroll
        for (int b = 0; b < 2; ++b)
#pragma unroll
            for (int m = 0; m < 4; ++m)
#pragma unroll
                for (int n = 0; n < 2; ++n) acc[a][b][m][n] = (f32x4){0.f, 0.f, 0.f, 0.f};
    bf16x8 At[4][2], B0[2][2], B1[2][2];
    const char* cA = (const char*)g.A + (size_t)cur.pm * tstep; const char* cB = (const char*)g.Bt + (size_t)cur.pn * tstep;
    S.a_ready(cur);
    if constexpr (SP2) {
        PG8_STAGE(PG8_SB(0, 0), cB, voffB); PG8_STAGE(PG8_SB(0, 1), cB + hstep, voffB); PG8_STAGE(PG8_SA(0, 0), cA, voffA); PG8_STAGE(PG8_SA(0, 1), cA + hstep, voffA);
        if (wr == 1) PG8_BAR;
        PG8_WAIT_V(2); PG8_BAR;
        PG8_STAGE(PG8_SB(1, 0), cB + kstep, voffB); PG8_STAGE(PG8_SA(1, 0), cA + kstep, voffA); PG8_STAGE(PG8_SB(1, 1), cB + hstep + kstep, voffB);
        PG8_WAIT_V(6); PG8_BAR;
    } else {
        PG8_STAGE(PG8_SB(0, 0), cB, voffB); PG8_STAGE(PG8_SA(0, 0), cA, voffA); PG8_STAGE(PG8_SB(0, 1), cB + hstep, voffB); PG8_STAGE(PG8_SA(0, 1), cA + hstep, voffA);
        if (wr == 1) PG8_BAR;
        PG8_WAIT_V(4); PG8_BAR;
        PG8_STAGE(PG8_SB(1, 0), cB + kstep, voffB); PG8_STAGE(PG8_SA(1, 0), cA + kstep, voffA); PG8_STAGE(PG8_SB(1, 1), cB + hstep + kstep, voffB);
        PG8_WAIT_V(6); PG8_BAR;
    }
    for (;;) {
        const bool has_next = S.next(ui + 1, nxt);
        const char* nA = has_next ? (const char*)g.A + (size_t)nxt.pm * tstep : cA; const char* nB = has_next ? (const char*)g.Bt + (size_t)nxt.pn * tstep : cB;
        for (int t = 0; t < nt; t += 2) {
            const bool last = (t == nt - 2);
            const char* a1 = cA + (size_t)(t + 1) * kstep;
            const char* a2 = last ? nA : cA + (size_t)(t + 2) * kstep; const char* b2 = last ? nB : cB + (size_t)(t + 2) * kstep;
            const char* a3 = a2 + kstep; const char* b3 = b2 + kstep;
            if (last && has_next) S.a_ready(nxt);
            if constexpr (SP2) {
            PG8_LDB(B0, 0, 0); PG8_LDB(B1, 0, 1); PG8_SCHED; PG8_LDA(At, 0, 0); PG8_STAGE(PG8_SA(1, 1), a1 + hstep, voffA);
            PG8_WAIT_V(8); PG8_WAIT_L(0); PG8_BAR; PG8_MMA(0, 0, At, B0); PG8_MMA(0, 1, At, B1); PG8_BAR; PG8_SCHED;
            PG8_LDA(At, 0, 1); PG8_STAGE(PG8_SB(0, 0), b2, voffB); PG8_STAGE(PG8_SB(0, 1), b2 + hstep, voffB); PG8_STAGE(PG8_SA(0, 0), a2, voffA);
            PG8_WAIT_V(8); PG8_WAIT_L(0); PG8_BAR; PG8_MMA(1, 0, At, B0); PG8_MMA(1, 1, At, B1); PG8_BAR; PG8_SCHED;
            PG8_LDB(B0, 1, 0); PG8_LDB(B1, 1, 1); PG8_SCHED; PG8_LDA(At, 1, 0); PG8_STAGE(PG8_SA(0, 1), a2 + hstep, voffA);
            PG8_WAIT_V(8); PG8_WAIT_L(0); PG8_BAR; PG8_MMA(0, 0, At, B0); PG8_MMA(0, 1, At, B1); PG8_BAR; PG8_SCHED;
            PG8_LDA(At, 1, 1); PG8_STAGE(PG8_SB(1, 0), b3, voffB); PG8_STAGE(PG8_SB(1, 1), b3 + hstep, voffB); PG8_STAGE(PG8_SA(1, 0), a3, voffA);
            PG8_WAIT_V(8); PG8_WAIT_L(0); PG8_BAR; PG8_MMA(1, 0, At, B0); PG8_MMA(1, 1, At, B1); PG8_BAR; PG8_SCHED;
            } else {
            PG8_LDB(B0, 0, 0); PG8_SCHED; PG8_LDA(At, 0, 0); PG8_STAGE(PG8_SA(1, 1), a1 + hstep, voffA);
            PG8_WAIT_L(8); PG8_BAR; PG8_WAIT_L(0); PG8_MMA(0, 0, At, B0); PG8_BAR; PG8_SCHED;
            PG8_LDB(B1, 0, 1); PG8_STAGE(PG8_SB(0, 0), b2, voffB);
            PG8_BAR; PG8_WAIT_L(0); PG8_MMA(0, 1, At, B1); PG8_BAR;
            PG8_LDA(At, 0, 1); PG8_STAGE(PG8_SA(0, 0), a2, voffA);
            PG8_BAR; PG8_WAIT_L(0); PG8_MMA(1, 0, At, B0); PG8_BAR; PG8_SCHED;
            PG8_STAGE(PG8_SB(0, 1), b2 + hstep, voffB);
            PG8_WAIT_V(6); PG8_BAR; PG8_MMA(1, 1, At, B1); PG8_BAR;
            PG8_LDB(B0, 1, 0); PG8_SCHED; PG8_LDA(At, 1, 0); PG8_STAGE(PG8_SA(0, 1), a2 + hstep, voffA);
            PG8_WAIT_L(8); PG8_BAR; PG8_WAIT_L(0); PG8_MMA(0, 0, At, B0); PG8_BAR; PG8_SCHED;
            PG8_LDB(B1, 1, 1); PG8_STAGE(PG8_SB(1, 0), b3, voffB);
            PG8_BAR; PG8_WAIT_L(0); PG8_MMA(0, 1, At, B1); PG8_BAR;
            PG8_LDA(At, 1, 1); PG8_STAGE(PG8_SA(1, 0), a3, voffA);
            PG8_BAR; PG8_WAIT_L(0); PG8_MMA(1, 0, At, B0); PG8_BAR; PG8_SCHED;
            PG8_STAGE(PG8_SB(1, 1), b3 + hstep, voffB);
            PG8_WAIT_V(6); PG8_BAR; PG8_MMA(1, 1, At, B1); PG8_BAR;
            }
        }
        if constexpr (ALIGN_EPI) { if (wr == 0) PG8_BAR; }
        if constexpr (!Epi::AFTER_DRAIN) { E(acc, cur, wr, wc, fr, fq); S.done(cur); }
        if (!has_next) break;
#pragma unroll
        for (int a = 0; a < 2; ++a)
#pragma unroll
            for (int b = 0; b < 2; ++b)
#pragma unroll
                for (int m = 0; m < 4; ++m)
#pragma unroll
                    for (int n = 0; n < 2; ++n) acc[a][b][m][n] = (f32x4){0.f, 0.f, 0.f, 0.f};
        cur = nxt; cA = nA; cB = nB; ++ui;
        if constexpr (ALIGN_EPI) { if (wr == 1) PG8_BAR; }
    }
    PG8_WAIT_V(0);
    if constexpr (!ALIGN_EPI) { if (wr == 0) PG8_BAR; }
    PG8_BAR;
    if constexpr (Epi::AFTER_DRAIN) { E.fused(acc, cur, wr, wc, fr, fq, lds, wid, lane); S.done(cur); }
#undef PG8_SA
#undef PG8_SB
#undef PG8_STAGE
#undef PG8_LDA
#undef PG8_LDB
#undef PG8_MMA
#undef PG8_WAIT_V
#undef PG8_WAIT_L
#undef PG8_BAR
#undef PG8_SCHED
}
}
namespace att {
#define ATT_LAS __attribute__((address_space(3)))
typedef short bf16x8 __attribute__((ext_vector_type(8)));
typedef short s16x4 __attribute__((ext_vector_type(4)));
typedef float f32x16 __attribute__((ext_vector_type(16)));
typedef unsigned u32x4 __attribute__((ext_vector_type(4)));
typedef unsigned u32x2 __attribute__((ext_vector_type(2)));
typedef unsigned short bf16_t;
constexpr int NKEY = 384;
constexpr int KCH = NKEY * 16 + 16;
constexpr int VH = NKEY * 64 + 64;
constexpr int LDS_K = 0, LDS_V = 8 * KCH, LDS_BYTES = LDS_V + 2 * VH;
constexpr int NUNITS = BATCH * NH * 4 * 32;
struct Tensors { const bf16_t* proj; bf16_t* oall; float* lse; const float* sinks; };
struct Unit { int kind, b, h, blk; };
__device__ __forceinline__ int crow(int r, int lh) { return (r & 3) + 8 * (r >> 2) + 4 * lh; }
__device__ __forceinline__ unsigned cvtpk(float lo, float hi) { unsigned r; asm("v_cvt_pk_bf16_f32 %0, %1, %2" : "=v"(r) : "v"(lo), "v"(hi)); return r; }
__device__ __forceinline__ s16x4 vtr(const ATT_LAS unsigned char* p) { typedef short v4i16_t __attribute__((ext_vector_type(4)));
    return __builtin_bit_cast(s16x4, __builtin_amdgcn_ds_read_tr16_b64_v4i16((ATT_LAS v4i16_t*)p)); }

struct Geom { int dil, res, n, qcol, kcol, vcol, ocol, maxs; size_t rowbase; };
__device__ __forceinline__ Geom geom(const Unit& u) {
    Geom g; const int k = u.kind;
    g.dil = (k <= 1) ? 1 : (k == 2 ? 4 : 16);
    const int nper = 32 / g.dil;
    g.res = u.blk / nper; g.n = u.blk % nper;
    g.qcol = (k == 0 ? QA_OFF : QB_OFF) + u.h * HD;
    g.kcol = (k == 0 ? KA_OFF + (u.h >> 3) * HD : KB_OFF + u.h * HD);
    g.vcol = (k == 0 ? VA_OFF + (u.h >> 3) * HD : VB_OFF + u.h * HD);
    g.ocol = k * 1024 + u.h * HD;
    g.maxs = (k == 0) ? 127 : 128;
    g.rowbase = (size_t)u.b * SEQ;
    return g;
}
__device__ __forceinline__ bool next_unit(int i, int vcu, int G, Unit& u) {
    if (G == 256) { if (i >= 32) return false; const int bh = (vcu >> 5) * 8 + (i >> 2); u.b = bh >> 4; u.h = bh & 15; u.kind = i & 3; u.blk = vcu & 31; return true; }
    const int id = i * G + vcu; if (id >= NUNITS) return false;
    u.blk = id & 31; u.kind = (id >> 5) & 3; const int bh = id >> 7; u.b = bh >> 4; u.h = bh & 15; return true;
}
struct Stage { u32x4 k[6], v[6]; };
__device__ __forceinline__ void stage_load(Stage& s, const Tensors& T, const Unit& u, int tid) {
    const Geom g = geom(u);
#pragma unroll
    for (int i = 0; i < 6; ++i) {
        const int cid = tid + 512 * i, j = cid >> 3, c = cid & 7;
        const int lk = 256 * g.n - 128 + j;
        if (lk >= 0) { const size_t row = g.rowbase + (size_t)lk * g.dil + g.res; const bf16_t* p = T.proj + row * DIN + c * 8;
            s.k[i] = *(const u32x4*)(p + g.kcol); s.v[i] = *(const u32x4*)(p + g.vcol); }
        else { s.k[i] = (u32x4){0u, 0u, 0u, 0u}; s.v[i] = (u32x4){0u, 0u, 0u, 0u}; }
    }
}
__device__ __forceinline__ void stage_write(const Stage& s, ATT_LAS unsigned char* lds, int tid) {
#pragma unroll
    for (int i = 0; i < 6; ++i) {
        const int cid = tid + 512 * i, j = cid >> 3, c = cid & 7;
        *(ATT_LAS u32x4*)(lds + LDS_K + c * KCH + j * 16) = s.k[i];
        *(ATT_LAS u32x4*)(lds + LDS_V + (c >> 2) * VH + j * 64 + (c & 3) * 16) = s.v[i];
    }
}
template <bool FIRST_OR_LAST>
__device__ __forceinline__ void tile_step(const ATT_LAS unsigned char* lds, int jt, int t, const bf16x8 (&qf)[4], const float (&cst)[16], float sl2, int maxs,
                                          int qi, int lh, int lane, float& m, float& lpart, f32x16 (&o)[2]) {
    const float tb = -sl2 * (float)(128 - 32 * t);
    f32x16 p;
#pragma unroll
    for (int r = 0; r < 16; ++r) p[r] = cst[r] + tb;
    const ATT_LAS unsigned char* kp = lds + LDS_K + lh * KCH + (jt + qi) * 16;
#pragma unroll
    for (int s = 0; s < 4; ++s) { const bf16x8 kf = *(const ATT_LAS bf16x8*)(kp + 2 * s * KCH); p = __builtin_amdgcn_mfma_f32_32x32x16_bf16(kf, qf[s], p, 0, 0, 0); }
    if (FIRST_OR_LAST) {
        const int sb = 128 - 32 * t + qi;
#pragma unroll
        for (int r = 0; r < 16; ++r) { const int st = sb - crow(r, lh); if (st < 0 || st > maxs) p[r] = -1e30f; }
    }
    float mx = p[0];
#pragma unroll
    for (int r = 1; r < 16; ++r) mx = fmaxf(mx, p[r]);
    { auto rr = __builtin_amdgcn_permlane32_swap(__float_as_uint(mx), __float_as_uint(mx), false, false); mx = fmaxf(__uint_as_float(rr[0]), __uint_as_float(rr[1])); }
    const float mn = fmaxf(m, mx);
    if (__any(mn > m)) { const float al = __builtin_amdgcn_exp2f(m - mn); lpart *= al;
#pragma unroll
        for (int r = 0; r < 16; ++r) { o[0][r] *= al; o[1][r] *= al; }
        m = mn; }
    float rs = 0.f;
#pragma unroll
    for (int r = 0; r < 16; ++r) { p[r] = __builtin_amdgcn_exp2f(p[r] - m); rs += p[r]; }
    lpart += rs;
    bf16x8 pb[2];
#pragma unroll
    for (int s = 0; s < 2; ++s) { u32x4 w; w.x = cvtpk(p[8 * s + 0], p[8 * s + 1]); w.y = cvtpk(p[8 * s + 2], p[8 * s + 3]); w.z = cvtpk(p[8 * s + 4], p[8 * s + 5]); w.w = cvtpk(p[8 * s + 6], p[8 * s + 7]);
        pb[s] = __builtin_bit_cast(bf16x8, w); }
    const ATT_LAS unsigned char* vp = lds + LDS_V + (jt + 4 * lh + ((lane & 15) >> 2)) * 64 + ((lane >> 4) & 1) * 32 + (lane & 3) * 8;
#pragma unroll
    for (int d0 = 0; d0 < 2; ++d0)
#pragma unroll
        for (int s = 0; s < 2; ++s) { const s16x4 lo = vtr(vp + d0 * VH + s * 1024), hi = vtr(vp + d0 * VH + s * 1024 + 512);
            const bf16x8 vf = (bf16x8){lo[0], lo[1], lo[2], lo[3], hi[0], hi[1], hi[2], hi[3]};
            o[d0] = __builtin_amdgcn_mfma_f32_32x32x16_bf16(vf, pb[s], o[d0], 0, 0, 0); }
}
__device__ __forceinline__ void unit_compute(const ATT_LAS unsigned char* lds, const Tensors& T, const Unit& u, int wave, int lane) {
    const Geom g = geom(u);
    const int qi = lane & 31, lh = lane >> 5;
    const int lq = 256 * g.n + 32 * wave + qi;
    const size_t qrow = g.rowbase + (size_t)lq * g.dil + g.res;
    bf16x8 qf[4];
#pragma unroll
    for (int s = 0; s < 4; ++s) qf[s] = *(const bf16x8*)(T.proj + qrow * DIN + g.qcol + 16 * s + 8 * lh);
    const float slope = exp2f(-0.5f * (float)(u.h + 1));
    const float sl2 = slope * LOG2E * (float)g.dil;
    float cst[16];
#pragma unroll
    for (int r = 0; r < 16; ++r) cst[r] = -sl2 * (float)(qi - crow(r, lh));
    float m, lpart;
    if (u.kind == 0) { m = T.sinks[u.h] * LOG2E; lpart = (lh == 0) ? 1.f : 0.f; }
    else { m = -1e30f; lpart = 0.f; }
    f32x16 o[2];
#pragma unroll
    for (int r = 0; r < 16; ++r) { o[0][r] = 0.f; o[1][r] = 0.f; }
    const int kb0 = 256 * g.n - 128 + 32 * wave;
    tile_step<true>(lds, 32 * (wave + 4), 4, qf, cst, sl2, g.maxs, qi, lh, lane, m, lpart, o);
    if (kb0 + 96 >= 0) tile_step<false>(lds, 32 * (wave + 3), 3, qf, cst, sl2, g.maxs, qi, lh, lane, m, lpart, o);
    if (kb0 + 64 >= 0) tile_step<false>(lds, 32 * (wave + 2), 2, qf, cst, sl2, g.maxs, qi, lh, lane, m, lpart, o);
    if (kb0 + 32 >= 0) tile_step<false>(lds, 32 * (wave + 1), 1, qf, cst, sl2, g.maxs, qi, lh, lane, m, lpart, o);
    if (kb0 >= 0)      tile_step<true>(lds, 32 * wave, 0, qf, cst, sl2, g.maxs, qi, lh, lane, m, lpart, o);
    float l;
    { auto rr = __builtin_amdgcn_permlane32_swap(__float_as_uint(lpart), __float_as_uint(lpart), false, false); l = __uint_as_float(rr[0]) + __uint_as_float(rr[1]); }
    const float inv = 1.0f / l;
    if (u.kind != 0 && lh == 0) T.lse[((size_t)(u.kind - 1) * MROWS + qrow) * NH + u.h] = m + log2f(l);
    bf16_t* op = T.oall + qrow * 4096 + g.ocol + 4 * lh;
#pragma unroll
    for (int d0 = 0; d0 < 2; ++d0)
#pragma unroll
        for (int q4 = 0; q4 < 4; ++q4) { u32x2 w; w.x = cvtpk(o[d0][4 * q4 + 0] * inv, o[d0][4 * q4 + 1] * inv); w.y = cvtpk(o[d0][4 * q4 + 2] * inv, o[d0][4 * q4 + 3] * inv);
            *(u32x2*)(op + 32 * d0 + 8 * q4) = w; }
}
__device__ __forceinline__ void phase(ATT_LAS unsigned char* lds, const Tensors& T, int vcu, int G, int tid, int wave, int lane) {
    Unit cur, nxt; Stage st;
    if (!next_unit(0, vcu, G, cur)) return;
    stage_load(st, T, cur, tid);
    for (int i = 0;; ++i) {
        __syncthreads();
        stage_write(st, lds, tid);
        __syncthreads();
        const bool has_next = next_unit(i + 1, vcu, G, nxt);
        if (has_next) stage_load(st, T, nxt, tid);
        unit_compute(lds, T, cur, wave, lane);
        if (!has_next) break;
        cur = nxt;
    }
    __syncthreads();
}
#undef ATT_LAS
}


constexpr int NWAVES = 8;
constexpr int N_LAUNCHES = MK_N_LAUNCHES;
constexpr int N_PHASES = 9;
constexpr size_t MiB = 1u << 20;
constexpr size_t WS_CTL = 0, CTL_ZERO_BYTES = 1 * MiB;
constexpr size_t WS_WIN = 2 * MiB;
constexpr size_t WS_WOUT = 19 * MiB;
constexpr size_t WS_W1 = 27 * MiB;
constexpr size_t WS_W2 = 59 * MiB;
constexpr size_t WS_LSE = 91 * MiB;
constexpr size_t WS_XN = 97 * MiB;
constexpr size_t WS_PROJ = 225 * MiB;
constexpr size_t WS_OALL = 497 * MiB;
constexpr size_t WS_U = 225 * MiB;
constexpr size_t WS_END = 753 * MiB;
static_assert(WS_WIN + (size_t)DIN * DM * 2 <= WS_WOUT && WS_WOUT + (size_t)DM * DM * 2 <= WS_W1 && WS_W1 + (size_t)FF * DM * 2 <= WS_W2 && WS_W2 + (size_t)DM * FF * 2 <= WS_LSE, "weights map");
static_assert(WS_LSE + (size_t)3 * MROWS * 16 * 4 <= WS_XN && WS_XN + (size_t)MROWS * DM * 2 <= WS_PROJ && WS_PROJ + (size_t)MROWS * DIN * 2 <= WS_OALL && WS_OALL + (size_t)MROWS * 4096 * 2 <= WS_END, "activation map");
static_assert(WS_U >= WS_XN + (size_t)MROWS * DM * 2 && WS_U + (size_t)MROWS * FF * 2 <= WS_END, "u overlay");
constexpr int CW_BAR = 4096;
constexpr int RING_OFF = 0, RING_BYTES = 131072;
constexpr int LDSCTL_OFF = RING_BYTES, MISC_OFF = LDSCTL_OFF + 320;
constexpr int LDS_BYTES = 147456;
static_assert(att::LDS_BYTES <= RING_BYTES && MISC_OFF + 128 <= LDS_BYTES, "LDS map");

#define GAS __attribute__((address_space(1)))
#define LAS __attribute__((address_space(3)))
typedef unsigned short bf16;
typedef unsigned v4u __attribute__((ext_vector_type(4)));
typedef float f32x4 __attribute__((ext_vector_type(4)));
typedef short bf16x8 __attribute__((ext_vector_type(8)));
typedef GAS unsigned gu32;
typedef GAS unsigned long long gu64;
#define RLX_AGENT __ATOMIC_RELAXED, __HIP_MEMORY_SCOPE_AGENT
#define LDS_WAIT() asm volatile("s_waitcnt lgkmcnt(0)" ::: "memory")
#define VM_WAIT() asm volatile("s_waitcnt vmcnt(0)" ::: "memory")
__device__ __forceinline__ unsigned long long rt() { return __builtin_amdgcn_s_memrealtime(); }
__device__ __forceinline__ unsigned f2bf(float f) { unsigned u = __builtin_bit_cast(unsigned, f); return (u + 0x7fffu + ((u >> 16) & 1u)) >> 16; }
__device__ __forceinline__ unsigned pk2(float lo, float hi) { return f2bf(lo) | (f2bf(hi) << 16); }

#define XB_TMO      128
#define XB_XCNT(j)  (256  + 64 * (j))
#define XB_XSUB(j)  (1280 + 64 * (j))
#define XB_XGEN(j)  (2304 + 64 * (j))
#define XB_TOP      3328
#define XB_TOPGEN   3392
#define XCD_BAR_WORDS 3456
#define XB_SPIN_CAP (1u << 18)

__device__ __forceinline__ unsigned xb_ld(unsigned* p)              { return __hip_atomic_load(p, __ATOMIC_RELAXED, __HIP_MEMORY_SCOPE_AGENT); }
__device__ __forceinline__ unsigned xb_add(unsigned* p, unsigned v) { return __hip_atomic_fetch_add(p, v, __ATOMIC_RELAXED, __HIP_MEMORY_SCOPE_AGENT); }
__device__ __forceinline__ unsigned xb_xcc_id() { return (unsigned)__builtin_amdgcn_s_getreg((3 << 11) | 20) & 0xFu; }
#define XB_SPIN(cond, bar) do { unsigned _sp = 0; while (cond) { __builtin_amdgcn_s_sleep(1); \
    if ((++_sp & 255u) == 0u) { if (xb_ld(&(bar)[XB_TMO])) break; if (_sp > XB_SPIN_CAP) { atomicAdd(&(bar)[XB_TMO], 1u); break; } } } } while (0)

struct XcdBarrier {
    unsigned* bar; unsigned x;
    volatile LAS unsigned* st;
};

__device__ __forceinline__ XcdBarrier xcd_barrier_post(unsigned* bar, volatile LAS unsigned* st) {
    XcdBarrier b; b.bar = bar; b.x = xb_xcc_id(); b.st = st;
    if (threadIdx.x == 0) (void)xb_add(&bar[XB_XCNT(b.x)], 1u);
    return b;
}
__device__ __forceinline__ void xcd_barrier_complete(unsigned* bar, unsigned x, unsigned& nloc, unsigned& nx) {
    const unsigned G = gridDim.x * gridDim.y * gridDim.z;
    unsigned sum, cnt, mine, sp = 0u;
    for (;;) {
        sum = 0u; cnt = 0u; mine = 0u;
#pragma unroll
        for (unsigned j = 0; j < 16; ++j) { const unsigned c = xb_ld(&bar[XB_XCNT(j)]); sum += c; cnt += (c > 0u) ? 1u : 0u; mine = (j == x) ? c : mine; }
        if (sum == G) break;
        __builtin_amdgcn_s_sleep(1);
        if ((++sp & 255u) == 0u) { if (xb_ld(&bar[XB_TMO])) break; if (sp > XB_SPIN_CAP) { atomicAdd(&bar[XB_TMO], 1u); break; } }
    }
    nloc = mine > 0u ? mine : 1u; nx = cnt > 0u ? cnt : 1u;
}

__device__ __forceinline__ void xcd_barrier(const XcdBarrier& b) {
    asm volatile("s_waitcnt vmcnt(0)" ::: "memory");
    __syncthreads();
    if (threadIdx.x == 0) {
        unsigned* bar = b.bar;
        __builtin_amdgcn_s_waitcnt(0);
        unsigned nloc = b.st[0], nx = b.st[1];
        if (nloc == 0u) { xcd_barrier_complete(bar, b.x, nloc, nx); b.st[0] = nloc; b.st[1] = nx; }
        const unsigned old = xb_add(&bar[XB_XSUB(b.x)], 1u);
        const unsigned gen = old / nloc;
        if (old + 1u == (gen + 1u) * nloc) {
            __builtin_amdgcn_fence(__ATOMIC_RELEASE, "agent");
            asm volatile("s_waitcnt vmcnt(0)" ::: "memory");
            const unsigned og = xb_add(&bar[XB_TOP], 1u);
            const unsigned tg = og / nx;
            if (og + 1u == (tg + 1u) * nx) xb_add(&bar[XB_TOPGEN], 1u);
            else XB_SPIN(xb_ld(&bar[XB_TOPGEN]) == tg, bar);
            __builtin_amdgcn_fence(__ATOMIC_ACQUIRE, "agent");
            xb_add(&bar[XB_XGEN(b.x)], 1u);
            asm volatile("s_waitcnt vmcnt(0)" ::: "memory");
        } else {
            XB_SPIN(xb_ld(&bar[XB_XGEN(b.x)]) == gen, bar);
            __builtin_amdgcn_fence(__ATOMIC_ACQUIRE, "agent");
            asm volatile("s_waitcnt vmcnt(0)" ::: "memory");
        }
    }
    __syncthreads();
}

__device__ __forceinline__ float wave_sum(float v) {
#pragma unroll
    for (int o = 1; o < 64; o <<= 1) v += __shfl_xor(v, o);
    return v;
}
__device__ __forceinline__ void p0_transpose_item(const float* W, int K, int N, bf16* WT, LAS float* scr, int item, int lane) {
    const int nblk = N / 32, kb = item / nblk, nb = item % nblk, k0 = 64 * kb, n0 = 32 * nb;
#pragma unroll 8
    for (int i = 0; i < 32; ++i) { const int kk = 2 * i + (lane >> 5); scr[kk * 33 + (lane & 31)] = W[(size_t)(k0 + kk) * N + n0 + (lane & 31)]; }
    LDS_WAIT(); asm volatile("" ::: "memory");
    const int c = lane & 7;
#pragma unroll
    for (int j = 0; j < 4; ++j) { const int n = (lane >> 3) + 8 * j; const LAS float* s = scr + (8 * c) * 33 + n;
        v4u o; o.x = pk2(s[0 * 33], s[1 * 33]); o.y = pk2(s[2 * 33], s[3 * 33]); o.z = pk2(s[4 * 33], s[5 * 33]); o.w = pk2(s[6 * 33], s[7 * 33]);
        *(GAS v4u*)(WT + (size_t)(n0 + n) * K + k0 + 8 * c) = o; }
    LDS_WAIT(); asm volatile("" ::: "memory");
}
__device__ __forceinline__ void rms_row_to_bf16(const float* xrow, const float* g, bf16* orow, int lane) {
    const GAS f32x4* xr = (const GAS f32x4*)xrow + lane; const GAS f32x4* gr = (const GAS f32x4*)g + lane;
    f32x4 v[8]; float s = 0.f;
#pragma unroll
    for (int j = 0; j < 8; ++j) { v[j] = xr[64 * j]; s += (v[j].x * v[j].x + v[j].y * v[j].y) + (v[j].z * v[j].z + v[j].w * v[j].w); }
    const float rstd = 1.0f / sqrtf(wave_sum(s) * (1.f / DM) + RMS_EPS);
    GAS unsigned long long* o8 = (GAS unsigned long long*)orow + lane;
#pragma unroll
    for (int j = 0; j < 8; ++j) { const f32x4 gg = gr[64 * j]; const f32x4 y = (v[j] * rstd) * gg;
        o8[64 * j] = (unsigned long long)pk2(y.x, y.y) | ((unsigned long long)pk2(y.z, y.w) << 32); }
}
__device__ __forceinline__ void rms_row_inplace(float* xrow, const float* g, int lane) {
    GAS f32x4* xr = (GAS f32x4*)xrow + lane; const GAS f32x4* gr = (const GAS f32x4*)g + lane;
    f32x4 v[8]; float s = 0.f;
#pragma unroll
    for (int j = 0; j < 8; ++j) { v[j] = xr[64 * j]; s += (v[j].x * v[j].x + v[j].y * v[j].y) + (v[j].z * v[j].z + v[j].w * v[j].w); }
    const float rstd = 1.0f / sqrtf(wave_sum(s) * (1.f / DM) + RMS_EPS);
#pragma unroll
    for (int j = 0; j < 8; ++j) { const f32x4 gg = gr[64 * j]; xr[64 * j] = (v[j] * rstd) * gg; }
}
__device__ __forceinline__ float bf_lo(unsigned w) { return __uint_as_float(w << 16); }
__device__ __forceinline__ float bf_hi(unsigned w) { return __uint_as_float(w & 0xffff0000u); }
__device__ __forceinline__ void combine_row(const bf16* orow  , const float* lse  , const float* ga, const float* gb, bf16* mrow  , int lane) {
    const GAS v4u* o4 = (const GAS v4u*)orow + 2 * lane;
    v4u ra[2], rb[3][2];
#pragma unroll
    for (int q = 0; q < 2; ++q) { ra[q] = o4[q]; rb[0][q] = o4[128 + q]; rb[1][q] = o4[256 + q]; rb[2][q] = o4[384 + q]; }
    const int head = lane >> 2;
    float l0 = lse[head], l1 = lse[(size_t)MROWS * 16 + head], l2 = lse[(size_t)2 * MROWS * 16 + head];
    const float lm = fmaxf(l0, fmaxf(l1, l2));
    float w0 = exp2f(l0 - lm), w1 = exp2f(l1 - lm), w2 = exp2f(l2 - lm);
    const float wi = 1.0f / (w0 + w1 + w2); w0 *= wi; w1 *= wi; w2 *= wi;
    float a[16], b[16]; float sa = 0.f, sb = 0.f;
#pragma unroll
    for (int q = 0; q < 2; ++q)
#pragma unroll
        for (int e = 0; e < 4; ++e) {
            const unsigned wa = ra[q][e], x0 = rb[0][q][e], x1 = rb[1][q][e], x2 = rb[2][q][e];
            const int i = q * 8 + e * 2;
            a[i] = bf_lo(wa); a[i + 1] = bf_hi(wa);
            b[i] = w0 * bf_lo(x0) + w1 * bf_lo(x1) + w2 * bf_lo(x2);
            b[i + 1] = w0 * bf_hi(x0) + w1 * bf_hi(x1) + w2 * bf_hi(x2);
            sa += a[i] * a[i] + a[i + 1] * a[i + 1]; sb += b[i] * b[i] + b[i + 1] * b[i + 1];
        }
    const float ra_ = 1.0f / sqrtf(wave_sum(sa) * (1.f / 1024.f) + RMS_EPS), rb_ = 1.0f / sqrtf(wave_sum(sb) * (1.f / 1024.f) + RMS_EPS);
    const GAS f32x4* ga4 = (const GAS f32x4*)ga + 4 * lane; const GAS f32x4* gb4 = (const GAS f32x4*)gb + 4 * lane;
    GAS v4u* m4 = (GAS v4u*)mrow + 2 * lane;
#pragma unroll
    for (int q = 0; q < 2; ++q) {
        const f32x4 g0 = ga4[2 * q], g1 = ga4[2 * q + 1], h0 = gb4[2 * q], h1 = gb4[2 * q + 1];
        v4u wa, wb; const int i = q * 8;
        wa.x = pk2(a[i + 0] * ra_ * g0.x, a[i + 1] * ra_ * g0.y); wa.y = pk2(a[i + 2] * ra_ * g0.z, a[i + 3] * ra_ * g0.w);
        wa.z = pk2(a[i + 4] * ra_ * g1.x, a[i + 5] * ra_ * g1.y); wa.w = pk2(a[i + 6] * ra_ * g1.z, a[i + 7] * ra_ * g1.w);
        wb.x = pk2(b[i + 0] * rb_ * h0.x, b[i + 1] * rb_ * h0.y); wb.y = pk2(b[i + 2] * rb_ * h0.z, b[i + 3] * rb_ * h0.w);
        wb.z = pk2(b[i + 4] * rb_ * h1.x, b[i + 5] * rb_ * h1.y); wb.w = pk2(b[i + 6] * rb_ * h1.z, b[i + 7] * rb_ * h1.w);
        m4[q] = wa; m4[128 + q] = wb;
    }
}

struct Args { const float* in[12]; float* out; unsigned char* ws; int ph_lo, ph_hi; };
__global__ void __launch_bounds__(NWAVES * 64, 2) block_fwd(Args args) {
    extern __shared__ __attribute__((aligned(16))) unsigned char lds_raw[];
    LAS unsigned char* lds = (LAS unsigned char*)lds_raw;
    volatile LAS unsigned* MISC = (volatile LAS unsigned*)(lds + MISC_OFF);
    const int tid = threadIdx.x, lane = tid & 63, wave = __builtin_amdgcn_readfirstlane(tid >> 6);
    const int G = gridDim.x; const int bx = blockIdx.x;
    const int vcu = (G % 8 == 0) ? (bx % 8) * (G / 8) + bx / 8 : bx;
    unsigned char* ws = args.ws;
    gu32* ctl = (gu32*)(ws + WS_CTL);
    const float* x = args.in[0]; const float* g_attn = args.in[1]; const float* w_in = args.in[2]; const float* b_in = args.in[3]; const float* sinks = args.in[4];
    const float* g_out_a = args.in[5]; const float* g_out_b = args.in[6]; const float* w_out = args.in[7]; const float* g_mlp = args.in[8];
    const float* w_1 = args.in[9]; const float* w_2 = args.in[10]; const float* g_final = args.in[11];
    float* out = args.out;
    bf16* Win_t = (bf16*)(ws + WS_WIN); bf16* Wout_t = (bf16*)(ws + WS_WOUT); bf16* W1_t = (bf16*)(ws + WS_W1); bf16* W2_t = (bf16*)(ws + WS_W2);
    float* LSE = (float*)(ws + WS_LSE); bf16* XN = (bf16*)(ws + WS_XN); bf16* PROJ = (bf16*)(ws + WS_PROJ); bf16* OALL = (bf16*)(ws + WS_OALL); bf16* U = (bf16*)(ws + WS_U);

    for (int u = tid; u < (LDS_BYTES - LDSCTL_OFF) / 4; u += NWAVES * 64) ((LAS unsigned*)(lds + LDSCTL_OFF))[u] = 0u;
    __syncthreads();
    XcdBarrier bar; bar.bar = (unsigned*)(ctl + CW_BAR); bar.x = 0; bar.st = nullptr;
    if (N_LAUNCHES == 1) bar = xcd_barrier_post((unsigned*)(ctl + CW_BAR), MISC + 8);
    const int lo = args.ph_lo, hi = args.ph_hi;
#define IN(k) (lo <= (k) && (k) < hi)
#define GRID_BAR(k) do { if (IN(k) && IN((k) + 1)) xcd_barrier(bar); } while (0)
    const int gw = vcu * NWAVES + wave, NGW = G * NWAVES;

    if (IN(0)) {
        LAS float* scr = (LAS float*)(lds + RING_OFF + wave * 16384);
        constexpr int I_IN = (DM / 64) * (DIN / 32), I_OUT = (DM / 64) * (DM / 32), I_1 = (DM / 64) * (FF / 32), I_2 = (FF / 64) * (DM / 32);
        constexpr int NITEMS = I_IN + I_OUT + I_1 + I_2;
        for (int it = gw; it < NITEMS; it += NGW) {
            int r = it;
            if (r < I_IN) { p0_transpose_item(w_in, DM, DIN, Win_t, scr, r, lane); continue; } r -= I_IN;
            if (r < I_OUT) { p0_transpose_item(w_out, DM, DM, Wout_t, scr, r, lane); continue; } r -= I_OUT;
            if (r < I_1) { p0_transpose_item(w_1, DM, FF, W1_t, scr, r, lane); continue; } r -= I_1;
            p0_transpose_item(w_2, FF, DM, W2_t, scr, r, lane);
        }
        for (int m = gw; m < MROWS; m += NGW) rms_row_to_bf16(x + (size_t)m * DM, g_attn, XN + (size_t)m * DM, lane);
    }
    GRID_BAR(0);
    if (IN(1)) {
        pg8::Gemm g{XN, Win_t, MROWS, DIN, DM}; pg8::StaticOrder S; S.init(MROWS, DIN, G, bx);
        pg8::EpiProj E{PROJ, DIN, b_in, QSCALE};
        pg8::gemm_phase<pg8::EpiProj, pg8::StaticOrder, true, true>(lds + RING_OFF, g, S, E);
    }
    GRID_BAR(1);
    if (IN(2)) {
        const att::Tensors T{PROJ, OALL, LSE, sinks};
        att::phase(lds + RING_OFF, T, vcu, G, tid, wave, lane);
    }
    GRID_BAR(2);
    if (IN(3)) {
        for (int m = gw; m < MROWS; m += NGW) combine_row(OALL + (size_t)m * 4096, LSE + (size_t)m * 16, g_out_a, g_out_b, XN + (size_t)m * DM, lane);
    }
    GRID_BAR(3);
    if (IN(4)) {
        pg8::Gemm g{XN, Wout_t, MROWS, DM, DM}; pg8::StaticOrder S; S.init(MROWS, DM, G, bx);
        pg8::EpiResF32 E{x, out, DM};
        pg8::gemm_phase<pg8::EpiResF32, pg8::StaticOrder, true, true>(lds + RING_OFF, g, S, E);
    }
    GRID_BAR(4);
    if (IN(5)) {
        for (int m = gw; m < MROWS; m += NGW) rms_row_to_bf16(out + (size_t)m * DM, g_mlp, XN + (size_t)m * DM, lane);
    }
    GRID_BAR(5);
    if (IN(6)) {
        pg8::Gemm g{XN, W1_t, MROWS, FF, DM}; pg8::StaticOrder S; S.init(MROWS, FF, G, bx);
        pg8::EpiRelu2 E{U, FF};
        pg8::gemm_phase<pg8::EpiRelu2, pg8::StaticOrder, true, true>(lds + RING_OFF, g, S, E);
    }
    GRID_BAR(6);
    if (IN(7)) {
        pg8::Gemm g{U, W2_t, MROWS, DM, FF}; pg8::StaticOrder S; S.init(MROWS, DM, G, bx);
        pg8::EpiResF32 E{out, out, DM};
        pg8::gemm_phase<pg8::EpiResF32, pg8::StaticOrder, true, true>(lds + RING_OFF, g, S, E);
    }
    GRID_BAR(7);
    if (IN(8)) {
        for (int m = gw; m < MROWS; m += NGW) rms_row_inplace(out + (size_t)m * DM, g_final, lane);
    }
#undef IN
#undef GRID_BAR
}

extern "C" void kernel_launch(void* const* d_in, const int* in_sizes, int n_in, void* d_out, int out_size, void* d_ws, size_t ws_size, hipStream_t stream) {
    static int grid = 0;
    if (grid == 0) {
        if (n_in != 12 || in_sizes[0] != MROWS * DM || out_size != MROWS * DM || ws_size < WS_END) {
            fprintf(stderr, "kernel_launch: built for 12 inputs, x/out of %d floats, >= %zu bytes of workspace; got n_in %d, in0 %d, out %d, ws %zu; nothing launched\n", MROWS * DM, (size_t)WS_END, n_in, n_in > 0 ? in_sizes[0] : -1, out_size, ws_size); grid = -1; return; }
        int dev = 0, cus = 0, per_cu = 0;
        if (hipGetDevice(&dev) != hipSuccess || hipDeviceGetAttribute(&cus, hipDeviceAttributeMultiprocessorCount, dev) != hipSuccess) { fprintf(stderr, "kernel_launch: device query failed\n"); grid = -1; return; }
        if (hipFuncSetAttribute((const void*)block_fwd, hipFuncAttributeMaxDynamicSharedMemorySize, LDS_BYTES) != hipSuccess) { fprintf(stderr, "kernel_launch: hipFuncSetAttribute failed\n"); grid = -1; return; }
        if (hipOccupancyMaxActiveBlocksPerMultiprocessor(&per_cu, (const void*)block_fwd, NWAVES * 64, LDS_BYTES) != hipSuccess || per_cu < 1)
            fprintf(stderr, "kernel_launch: note: occupancy query reports %d workgroups per CU\n", per_cu);
        (void)hipGetLastError();
        grid = cus;
    }
    if (grid < 0) return;
    if (hipMemsetAsync((char*)d_ws + WS_CTL, 0, CTL_ZERO_BYTES, stream) != hipSuccess) { fprintf(stderr, "kernel_launch: memset failed\n"); return; }
    Args a{};
    for (int i = 0; i < 12; ++i) a.in[i] = (const float*)d_in[i];
    a.out = (float*)d_out; a.ws = (unsigned char*)d_ws;
    if (N_LAUNCHES == 1) { a.ph_lo = 0; a.ph_hi = N_PHASES; hipLaunchKernelGGL(block_fwd, dim3(grid), dim3(NWAVES * 64), LDS_BYTES, stream, a); }
    else for (int li = 0; li < N_PHASES; ++li) { a.ph_lo = li; a.ph_hi = li + 1; hipLaunchKernelGGL(block_fwd, dim3(grid), dim3(NWAVES * 64), LDS_BYTES, stream, a); }
    const hipError_t le = hipPeekAtLastError();
    if (le != hipSuccess) fprintf(stderr, "kernel_launch: launch failed: %s\n", hipGetErrorName(le));
}
```

```cpp
#include <hip/hip_runtime.h>
#include <hip/hip_bf16.h>
#include <cstdio>
#include <cstdint>

#ifndef MK_N_LAUNCHES
#define MK_N_LAUNCHES 1
#endif

constexpr int BATCH = 4, SEQ = 8192, DM = 2048, DIN = 4352, FF = 8192, NH = 16, HD = 64;
constexpr int MROWS = BATCH * SEQ;
constexpr int QA_OFF = 0, KA_OFF = 1024, VA_OFF = 1152, QB_OFF = 1280, KB_OFF = 2304, VB_OFF = 3328;
constexpr float RMS_EPS = 1e-5f;
constexpr float LOG2E = 1.4426950408889634f;
constexpr float QSCALE = 0.125f * LOG2E;

namespace pg8 {
#define PG8_LAS __attribute__((address_space(3)))
typedef unsigned short bf16_t;
typedef short bf16x8 __attribute__((ext_vector_type(8)));
typedef float f32x4 __attribute__((ext_vector_type(4)));
typedef unsigned u32x4 __attribute__((ext_vector_type(4)));
constexpr int BM = 256, BK = 64, HALF = 128, HTB = HALF * BK * 2  , STAGE_BYTES = 8 * HTB, NXCD = 8, WGM = 8;

__host__ __device__ __forceinline__ int lds_byte(int r, int c) { const int st = (r >> 4) * 2 + (c >> 5), rr = r & 15, cc = c & 31, ob = rr * 64 + cc * 2; return st * 1024 + (ob ^ (((ob >> 9) & 1) << 5)); }
__host__ __device__ __forceinline__ void stage_rc(int b, int& R, int& C) { const int st = b / 1024, sb = b % 1024, swz = sb ^ (((sb >> 9) & 1) << 5); R = (st >> 1) * 16 + swz / 64; C = (st & 1) * 32 + (swz % 64) / 2; }
__host__ __device__ __forceinline__ int perm32(int rho) { const int n = rho >> 4, i = rho & 15; return 8 * (i >> 2) + 4 * n + (i & 3); }

struct Unit { int pm, pn; };
struct Gemm { const bf16_t* A; const bf16_t* Bt; int M, N, K; };

struct StaticOrder {
    int nM, nN, nwg, G, c;
    __host__ __device__ void init(int M, int N, int G_, int c_) { nM = M / BM; nN = N / BM; nwg = nM * nN; G = G_; c = c_; }
    __host__ __device__ bool next(int i, Unit& u) const {
        const long L = (long)i * G + c; if (L >= nwg) return false;
        int wgid = (int)L; { const int q = nwg / NXCD, r = nwg % NXCD, xcd = wgid % NXCD, off = wgid / NXCD; wgid = (xcd < r ? xcd * (q + 1) : r * (q + 1) + (xcd - r) * q) + off; }
        const int nig = WGM * nN, gid = wgid / nig, fm = gid * WGM, gsz = (nM - fm) < WGM ? (nM - fm) : WGM;
        u.pm = fm + ((wgid % nig) % gsz); u.pn = (wgid % nig) / gsz; return true;
    }
    __device__ __forceinline__ void a_ready(const Unit&) const {}
    __device__ __forceinline__ void done(const Unit&) const {}
};

__device__ __forceinline__ unsigned cvt_pk_bf16(float lo, float hi) { unsigned r; asm volatile("v_cvt_pk_bf16_f32 %0, %1, %2" : "=v"(r) : "v"(lo), "v"(hi)); return r; }

struct EpiProj {
    static constexpr bool PERM = true, AFTER_DRAIN = false;
    bf16_t* O; int ldc; const float* bias; float qscale;
    __device__ __forceinline__ void operator()(const f32x4 (&acc)[2][2][4][2], const Unit& u, int wr, int wc, int fr, int fq) const {
        const int row0 = u.pm * BM + wr * 64 + fr;
        const float sc = (u.pn < 4 || (u.pn >= 5 && u.pn < 9)) ? qscale : 1.f;
        const int col0 = u.pn * BM + wc * 32 + 8 * fq;
        f32x4 bv[2][2];
#pragma unroll
        for (int bj = 0; bj < 2; ++bj)
#pragma unroll
            for (int n = 0; n < 2; ++n) bv[bj][n] = *(const f32x4*)(bias + col0 + bj * HALF + 4 * n);
#pragma unroll
        for (int ai = 0; ai < 2; ++ai)
#pragma unroll
            for (int m = 0; m < 4; ++m) { bf16_t* rowp = O + (size_t)(row0 + ai * HALF + m * 16) * ldc + col0;
#pragma unroll
                for (int bj = 0; bj < 2; ++bj) { f32x4 v0 = (acc[ai][bj][m][0] + bv[bj][0]) * sc, v1 = (acc[ai][bj][m][1] + bv[bj][1]) * sc;
                    u32x4 w; w.x = cvt_pk_bf16(v0[0], v0[1]); w.y = cvt_pk_bf16(v0[2], v0[3]); w.z = cvt_pk_bf16(v1[0], v1[1]); w.w = cvt_pk_bf16(v1[2], v1[3]);
                    *(u32x4*)(rowp + bj * HALF) = w; } }
    }
};
struct EpiRelu2 {
    static constexpr bool PERM = true, AFTER_DRAIN = false;
    bf16_t* O; int ldc;
    __device__ __forceinline__ void operator()(const f32x4 (&acc)[2][2][4][2], const Unit& u, int wr, int wc, int fr, int fq) const {
        const int row0 = u.pm * BM + wr * 64 + fr;
        const int col0 = u.pn * BM + wc * 32 + 8 * fq;
#pragma unroll
        for (int ai = 0; ai < 2; ++ai)
#pragma unroll
            for (int m = 0; m < 4; ++m) { bf16_t* rowp = O + (size_t)(row0 + ai * HALF + m * 16) * ldc + col0;
#pragma unroll
                for (int bj = 0; bj < 2; ++bj) { f32x4 v0 = acc[ai][bj][m][0], v1 = acc[ai][bj][m][1];
#pragma unroll
                    for (int e = 0; e < 4; ++e) { const float a = fmaxf(v0[e], 0.f), b = fmaxf(v1[e], 0.f); v0[e] = a * a; v1[e] = b * b; }
                    u32x4 w; w.x = cvt_pk_bf16(v0[0], v0[1]); w.y = cvt_pk_bf16(v0[2], v0[3]); w.z = cvt_pk_bf16(v1[0], v1[1]); w.w = cvt_pk_bf16(v1[2], v1[3]);
                    *(u32x4*)(rowp + bj * HALF) = w; } }
    }
};
struct EpiResF32 {
    static constexpr bool PERM = false, AFTER_DRAIN = false;
    const float* base; float* out; int ldc;
    __device__ __forceinline__ void operator()(const f32x4 (&acc)[2][2][4][2], const Unit& u, int wr, int wc, int fr, int fq) const {
        const int row0 = u.pm * BM + wr * 64 + fr, col0 = u.pn * BM + wc * 32 + 4 * fq;
#pragma unroll
        for (int ai = 0; ai < 2; ++ai)
#pragma unroll
            for (int m = 0; m < 4; ++m) { const size_t off = (size_t)(row0 + ai * HALF + m * 16) * ldc + col0;
                f32x4 bs[2][2];
#pragma unroll
                for (int bj = 0; bj < 2; ++bj)
#pragma unroll
                    for (int n = 0; n < 2; ++n) bs[bj][n] = *(const f32x4*)(base + off + bj * HALF + n * 16);
#pragma unroll
                for (int bj = 0; bj < 2; ++bj)
#pragma unroll
                    for (int n = 0; n < 2; ++n) *(f32x4*)(out + off + bj * HALF + n * 16) = bs[bj][n] + acc[ai][bj][m][n];
                if (m & 1) asm volatile("" ::: "memory"); }
    }
};

template <class Epi, class Sched, bool ALIGN_EPI = false, bool SP2 = false>
__device__ __forceinline__ void gemm_phase(PG8_LAS unsigned char* lds, const Gemm g, const Sched& S, const Epi& E) {
    const int tid = threadIdx.x, wid = __builtin_amdgcn_readfirstlane(tid >> 6), lane = tid & 63, wr = wid >> 2, wc = wid & 3, fr = lane & 15, fq = lane >> 4;
    const int K = g.K, nt = K / BK;
    unsigned voffA[2], voffB[2];
#pragma unroll
    for (int i = 0; i < 2; ++i) { int R, C; stage_rc(tid * 16 + i * 8192, R, C); const int Rb = Epi::PERM ? ((R & ~31) + perm32(R & 31)) : R;
        voffA[i] = (unsigned)(R * K + C) * 2u; voffB[i] = (unsigned)(Rb * K + C) * 2u; }
    const size_t kstep = (size_t)(BK * 2);
    const size_t hstep = (size_t)HALF * K * 2;
    const size_t tstep = 2 * hstep;
    const unsigned ldsw = (unsigned)wid * 1024u;
    const int aoff = lds_byte(wr * 64 + fr, fq * 8), boff = lds_byte(wc * 32 + fr, fq * 8);
#define PG8_SA(b, h) (((b) * 2 + (h)) * HTB)
#define PG8_SB(b, h) ((4 + (b) * 2 + (h)) * HTB)
#define PG8_STAGE(bufoff, gbase, voff) do { _Pragma("unroll") for (int _i = 0; _i < 2; ++_i) \
        __builtin_amdgcn_global_load_lds((const unsigned*)((const char*)(gbase) + (voff)[_i]), (PG8_LAS unsigned*)(lds + (bufoff) + ldsw + _i * 8192), 16, 0, 0); } while (0)
#define PG8_LDA(dst, b, h) do { _Pragma("unroll") for (int m = 0; m < 4; ++m) _Pragma("unroll") for (int k = 0; k < 2; ++k) dst[m][k] = *(const PG8_LAS bf16x8*)(lds + PG8_SA(b, h) + aoff + m * 2048 + k * 1024); } while (0)
#define PG8_LDB(dst, b, h) do { _Pragma("unroll") for (int n = 0; n < 2; ++n) _Pragma("unroll") for (int k = 0; k < 2; ++k) dst[n][k] = *(const PG8_LAS bf16x8*)(lds + PG8_SB(b, h) + boff + n * 2048 + k * 1024); } while (0)
#define PG8_MMA(ai, bj, At, Bt) do { __builtin_amdgcn_s_setprio(1); _Pragma("unroll") for (int m = 0; m < 4; ++m) _Pragma("unroll") for (int n = 0; n < 2; ++n) _Pragma("unroll") for (int k = 0; k < 2; ++k) \
        acc[ai][bj][m][n] = __builtin_amdgcn_mfma_f32_16x16x32_bf16(Bt[n][k], At[m][k], acc[ai][bj][m][n], 0, 0, 0); __builtin_amdgcn_s_setprio(0); } while (0)
#define PG8_WAIT_V(n) asm volatile("s_waitcnt vmcnt(" #n ")" ::: "memory")
#define PG8_WAIT_L(n) asm volatile("s_waitcnt lgkmcnt(" #n ")" ::: "memory")
#define PG8_BAR __builtin_amdgcn_s_barrier()
#define PG8_SCHED __builtin_amdgcn_sched_barrier(0)
    Unit cur, nxt; int ui = 0;
    if (!S.next(0, cur)) return;
    f32x4 acc[2][2][4][2];
#pragma unroll
    for (int a = 0; a < 2; ++a)
#pragma unroll
        for (int b = 0; b < 2; ++b)
#pragma unroll
            for (int m = 0; m < 4; ++m)
#pragma unroll
                for (int n = 0; n < 2; ++n) acc[a][b][m][n] = (f32x4){0.f, 0.f, 0.f, 0.f};
    bf16x8 At[4][2], B0[2][2], B1[2][2];
    const char* cA = (const char*)g.A + (size_t)cur.pm * tstep; const char* cB = (const char*)g.Bt + (size_t)cur.pn * tstep;
    S.a_ready(cur);
    if constexpr (SP2) {
        PG8_STAGE(PG8_SB(0, 0), cB, voffB); PG8_STAGE(PG8_SB(0, 1), cB + hstep, voffB); PG8_STAGE(PG8_SA(0, 0), cA, voffA); PG8_STAGE(PG8_SA(0, 1), cA + hstep, voffA);
        if (wr == 1) PG8_BAR;
        PG8_WAIT_V(2); PG8_BAR;
        PG8_STAGE(PG8_SB(1, 0), cB + kstep, voffB); PG8_STAGE(PG8_SA(1, 0), cA + kstep, voffA); PG8_STAGE(PG8_SB(1, 1), cB + hstep + kstep, voffB);
        PG8_WAIT_V(6); PG8_BAR;
    } else {
        PG8_STAGE(PG8_SB(0, 0), cB, voffB); PG8_STAGE(PG8_SA(0, 0), cA, voffA); PG8_STAGE(PG8_SB(0, 1), cB + hstep, voffB); PG8_STAGE(PG8_SA(0, 1), cA + hstep, voffA);
        if (wr == 1) PG8_BAR;
        PG8_WAIT_V(4); PG8_BAR;
        PG8_STAGE(PG8_SB(1, 0), cB + kstep, voffB); PG8_STAGE(PG8_SA(1, 0), cA + kstep, voffA); PG8_STAGE(PG8_SB(1, 1), cB + hstep + kstep, voffB);
        PG8_WAIT_V(6); PG8_BAR;
    }
    for (;;) {
        const bool has_next = S.next(ui + 1, nxt);
        const char* nA = has_next ? (const char*)g.A + (size_t)nxt.pm * tstep : cA; const char* nB = has_next ? (const char*)g.Bt + (size_t)nxt.pn * tstep : cB;
        for (int t = 0; t < nt; t += 2) {
            const bool last = (t == nt - 2);
            const char* a1 = cA + (size_t)(t + 1) * kstep;
            const char* a2 = last ? nA : cA + (size_t)(t + 2) * kstep; const char* b2 = last ? nB : cB + (size_t)(t + 2) * kstep;
            const char* a3 = a2 + kstep; const char* b3 = b2 + kstep;
            if (last && has_next) S.a_ready(nxt);
            if constexpr (SP2) {
            PG8_LDB(B0, 0, 0); PG8_LDB(B1, 0, 1); PG8_SCHED; PG8_LDA(At, 0, 0); PG8_STAGE(PG8_SA(1, 1), a1 + hstep, voffA);
            PG8_WAIT_V(8); PG8_WAIT_L(0); PG8_BAR; PG8_MMA(0, 0, At, B0); PG8_MMA(0, 1, At, B1); PG8_BAR; PG8_SCHED;
            PG8_LDA(At, 0, 1); PG8_STAGE(PG8_SB(0, 0), b2, voffB); PG8_STAGE(PG8_SB(0, 1), b2 + hstep, voffB); PG8_STAGE(PG8_SA(0, 0), a2, voffA);
            PG8_WAIT_V(8); PG8_WAIT_L(0); PG8_BAR; PG8_MMA(1, 0, At, B0); PG8_MMA(1, 1, At, B1); PG8_BAR; PG8_SCHED;
            PG8_LDB(B0, 1, 0); PG8_LDB(B1, 1, 1); PG8_SCHED; PG8_LDA(At, 1, 0); PG8_STAGE(PG8_SA(0, 1), a2 + hstep, voffA);
            PG8_WAIT_V(8); PG8_WAIT_L(0); PG8_BAR; PG8_MMA(0, 0, At, B0); PG8_MMA(0, 1, At, B1); PG8_BAR; PG8_SCHED;
            PG8_LDA(At, 1, 1); PG8_STAGE(PG8_SB(1, 0), b3, voffB); PG8_STAGE(PG8_SB(1, 1), b3 + hstep, voffB); PG8_STAGE(PG8_SA(1, 0), a3, voffA);
            PG8_WAIT_V(8); PG8_WAIT_L(0); PG8_BAR; PG8_MMA(1, 0, At, B0); PG8_MMA(1, 1, At, B1); PG8_BAR; PG8_SCHED;
            } else {
            PG8_LDB(B0, 0, 0); PG8_SCHED; PG8_LDA(At, 0, 0); PG8_STAGE(PG8_SA(1, 1), a1 + hstep, voffA);
            PG8_WAIT_L(8); PG8_BAR; PG8_WAIT_L(0); PG8_MMA(0, 0, At, B0); PG8_BAR; PG8_SCHED;
            PG8_LDB(B1, 0, 1); PG8_STAGE(PG8_SB(0, 0), b2, voffB);
            PG8_BAR; PG8_WAIT_L(0); PG8_MMA(0, 1, At, B1); PG8_BAR;
            PG8_LDA(At, 0, 1); PG8_STAGE(PG8_SA(0, 0), a2, voffA);
            PG8_BAR; PG8_WAIT_L(0); PG8_MMA(1, 0, At, B0); PG8_BAR; PG8_SCHED;
            PG8_STAGE(PG8_SB(0, 1), b2 + hstep, voffB);
            PG8_WAIT_V(6); PG8_BAR; PG8_MMA(1, 1, At, B1); PG8_BAR;
            PG8_LDB(B0, 1, 0); PG8_SCHED; PG8_LDA(At, 1, 0); PG8_STAGE(PG8_SA(0, 1), a2 + hstep, voffA);
            PG8_WAIT_L(8); PG8_BAR; PG8_WAIT_L(0); PG8_MMA(0, 0, At, B0); PG8_BAR; PG8_SCHED;
            PG8_LDB(B1, 1, 1); PG8_STAGE(PG8_SB(1, 0), b3, voffB);
            PG8_BAR; PG8_WAIT_L(0); PG8_MMA(0, 1, At, B1); PG8_BAR;
            PG8_LDA(At, 1, 1); PG8_STAGE(PG8_SA(1, 0), a3, voffA);
            PG8_BAR; PG8_WAIT_L(0); PG8_MMA(1, 0, At, B0); PG8_BAR; PG8_SCHED;
            PG8_STAGE(PG8_SB(1, 1), b3 + hstep, voffB);
            PG8_WAIT_V(6); PG8_BAR; PG8_MMA(1, 1, At, B1); PG8_BAR;
            }
        }
        if constexpr (ALIGN_EPI) { if (wr == 0) PG8_BAR; }
        if constexpr (!Epi::AFTER_DRAIN) { E(acc, cur, wr, wc, fr, fq); S.done(cur); }
        if (!has_next) break;
#pragma unroll
        for (int a = 0; a < 2; ++a)
#pragma unroll
            for (int b = 0; b < 2; ++b)
#pragma unroll
                for (int m = 0; m < 4; ++m)
#pragma unroll
                    for (int n = 0; n < 2; ++n) acc[a][b][m][n] = (f32x4){0.f, 0.f, 0.f, 0.f};
        cur = nxt; cA = nA; cB = nB; ++ui;
        if constexpr (ALIGN_EPI) { if (wr == 1) PG8_BAR; }
    }
    PG8_WAIT_V(0);
    if constexpr (!ALIGN_EPI) { if (wr == 0) PG8_BAR; }
    PG8_BAR;
    if constexpr (Epi::AFTER_DRAIN) { E.fused(acc, cur, wr, wc, fr, fq, lds, wid, lane); S.done(cur); }
#undef PG8_SA
#undef PG8_SB
#undef PG8_STAGE
#undef PG8_LDA
#undef PG8_LDB
#undef PG8_MMA
#undef PG8_WAIT_V
#undef PG8_WAIT_L
#undef PG8_BAR
#undef PG8_SCHED
}
}
namespace att {
#define ATT_LAS __attribute__((address_space(3)))
typedef short bf16x8 __attribute__((ext_vector_type(8)));
typedef short s16x4 __attribute__((ext_vector_type(4)));
typedef float f32x16 __attribute__((ext_vector_type(16)));
typedef unsigned u32x4 __attribute__((ext_vector_type(4)));
typedef unsigned u32x2 __attribute__((ext_vector_type(2)));
typedef unsigned short bf16_t;
constexpr int NKEY = 384;
constexpr int KCH = NKEY * 16 + 16;
constexpr int VH = NKEY * 64 + 64;
constexpr int LDS_K = 0, LDS_V = 8 * KCH, LDS_BYTES = LDS_V + 2 * VH;
constexpr int NUNITS = BATCH * NH * 4 * 32;
struct Tensors { const bf16_t* proj; bf16_t* oall; float* lse; const float* sinks; };
struct Unit { int kind, b, h, blk; };
__device__ __forceinline__ int crow(int r, int lh) { return (r & 3) + 8 * (r >> 2) + 4 * lh; }
__device__ __forceinline__ unsigned cvtpk(float lo, float hi) { unsigned r; asm("v_cvt_pk_bf16_f32 %0, %1, %2" : "=v"(r) : "v"(lo), "v"(hi)); return r; }
__device__ __forceinline__ s16x4 vtr(const ATT_LAS unsigned char* p) { typedef short v4i16_t __attribute__((ext_vector_type(4)));
    return __builtin_bit_cast(s16x4, __builtin_amdgcn_ds_read_tr16_b64_v4i16((ATT_LAS v4i16_t*)p)); }

struct Geom { int dil, res, n, qcol, kcol, vcol, ocol, maxs; size_t rowbase; };
__device__ __forceinline__ Geom geom(const Unit& u) {
    Geom g; const int k = u.kind;
    g.dil = (k <= 1) ? 1 : (k == 2 ? 4 : 16);
    const int nper = 32 / g.dil;
    g.res = u.blk / nper; g.n = u.blk % nper;
    g.qcol = (k == 0 ? QA_OFF : QB_OFF) + u.h * HD;
    g.kcol = (k == 0 ? KA_OFF + (u.h >> 3) * HD : KB_OFF + u.h * HD);
    g.vcol = (k == 0 ? VA_OFF + (u.h >> 3) * HD : VB_OFF + u.h * HD);
    g.ocol = k * 1024 + u.h * HD;
    g.maxs = (k == 0) ? 127 : 128;
    g.rowbase = (size_t)u.b * SEQ;
    return g;
}
__device__ __forceinline__ bool next_unit(int i, int vcu, int G, Unit& u) {
    if (G == 256) { if (i >= 32) return false; const int bh = (vcu >> 5) * 8 + (i >> 2); u.b = bh >> 4; u.h = bh & 15; u.kind = i & 3; u.blk = vcu & 31; return true; }
    const int id = i * G + vcu; if (id >= NUNITS) return false;
    u.blk = id & 31; u.kind = (id >> 5) & 3; const int bh = id >> 7; u.b = bh >> 4; u.h = bh & 15; return true;
}
struct Stage { u32x4 k[6], v[6]; };
__device__ __forceinline__ void stage_load(Stage& s, const Tensors& T, const Unit& u, int tid) {
    const Geom g = geom(u);
#pragma unroll
    for (int i = 0; i < 6; ++i) {
        const int cid = tid + 512 * i, j = cid >> 3, c = cid & 7;
        const int lk = 256 * g.n - 128 + j;
        if (lk >= 0) { const size_t row = g.rowbase + (size_t)lk * g.dil + g.res; const bf16_t* p = T.proj + row * DIN + c * 8;
            s.k[i] = *(const u32x4*)(p + g.kcol); s.v[i] = *(const u32x4*)(p + g.vcol); }
        else { s.k[i] = (u32x4){0u, 0u, 0u, 0u}; s.v[i] = (u32x4){0u, 0u, 0u, 0u}; }
    }
}
__device__ __forceinline__ void stage_write(const Stage& s, ATT_LAS unsigned char* lds, int tid) {
#pragma unroll
    for (int i = 0; i < 6; ++i) {
        const int cid = tid + 512 * i, j = cid >> 3, c = cid & 7;
        *(ATT_LAS u32x4*)(lds + LDS_K + c * KCH + j * 16) = s.k[i];
        *(ATT_LAS u32x4*)(lds + LDS_V + (c >> 2) * VH + j * 64 + (c & 3) * 16) = s.v[i];
    }
}
template <bool FIRST_OR_LAST>
__device__ __forceinline__ void tile_step(const ATT_LAS unsigned char* lds, int jt, int t, const bf16x8 (&qf)[4], const float (&cst)[16], float sl2, int maxs,
                                          int qi, int lh, int lane, float& m, float& lpart, f32x16 (&o)[2]) {
    const float tb = -sl2 * (float)(128 - 32 * t);
    f32x16 p;
#pragma unroll
    for (int r = 0; r < 16; ++r) p[r] = cst[r] + tb;
    const ATT_LAS unsigned char* kp = lds + LDS_K + lh * KCH + (jt + qi) * 16;
#pragma unroll
    for (int s = 0; s < 4; ++s) { const bf16x8 kf = *(const ATT_LAS bf16x8*)(kp + 2 * s * KCH); p = __builtin_amdgcn_mfma_f32_32x32x16_bf16(kf, qf[s], p, 0, 0, 0); }
    if (FIRST_OR_LAST) {
        const int sb = 128 - 32 * t + qi;
#pragma unroll
        for (int r = 0; r < 16; ++r) { const int st = sb - crow(r, lh); if (st < 0 || st > maxs) p[r] = -1e30f; }
    }
    float mx = p[0];
#pragma unroll
    for (int r = 1; r < 16; ++r) mx = fmaxf(mx, p[r]);
    { auto rr = __builtin_amdgcn_permlane32_swap(__float_as_uint(mx), __float_as_uint(mx), false, false); mx = fmaxf(__uint_as_float(rr[0]), __uint_as_float(rr[1])); }
    const float mn = fmaxf(m, mx);
    if (__any(mn > m)) { const float al = __builtin_amdgcn_exp2f(m - mn); lpart *= al;
#pragma unroll
        for (int r = 0; r < 16; ++r) { o[0][r] *= al; o[1][r] *= al; }
        m = mn; }
    float rs = 0.f;
#pragma unroll
    for (int r = 0; r < 16; ++r) { p[r] = __builtin_amdgcn_exp2f(p[r] - m); rs += p[r]; }
    lpart += rs;
    bf16x8 pb[2];
#pragma unroll
    for (int s = 0; s < 2; ++s) { u32x4 w; w.x = cvtpk(p[8 * s + 0], p[8 * s + 1]); w.y = cvtpk(p[8 * s + 2], p[8 * s + 3]); w.z = cvtpk(p[8 * s + 4], p[8 * s + 5]); w.w = cvtpk(p[8 * s + 6], p[8 * s + 7]);
        pb[s] = __builtin_bit_cast(bf16x8, w); }
    const ATT_LAS unsigned char* vp = lds + LDS_V + (jt + 4 * lh + ((lane & 15) >> 2)) * 64 + ((lane >> 4) & 1) * 32 + (lane & 3) * 8;
#pragma unroll
    for (int d0 = 0; d0 < 2; ++d0)
#pragma unroll
        for (int s = 0; s < 2; ++s) { const s16x4 lo = vtr(vp + d0 * VH + s * 1024), hi = vtr(vp + d0 * VH + s * 1024 + 512);
            const bf16x8 vf = (bf16x8){lo[0], lo[1], lo[2], lo[3], hi[0], hi[1], hi[2], hi[3]};
            o[d0] = __builtin_amdgcn_mfma_f32_32x32x16_bf16(vf, pb[s], o[d0], 0, 0, 0); }
}
__device__ __forceinline__ void unit_compute(const ATT_LAS unsigned char* lds, const Tensors& T, const Unit& u, int wave, int lane) {
    const Geom g = geom(u);
    const int qi = lane & 31, lh = lane >> 5;
    const int lq = 256 * g.n + 32 * wave + qi;
    const size_t qrow = g.rowbase + (size_t)lq * g.dil + g.res;
    bf16x8 qf[4];
#pragma unroll
    for (int s = 0; s < 4; ++s) qf[s] = *(const bf16x8*)(T.proj + qrow * DIN + g.qcol + 16 * s + 8 * lh);
    const float slope = exp2f(-0.5f * (float)(u.h + 1));
    const float sl2 = slope * LOG2E * (float)g.dil;
    float cst[16];
#pragma unroll
    for (int r = 0; r < 16; ++r) cst[r] = -sl2 * (float)(qi - crow(r, lh));
    float m, lpart;
    if (u.kind == 0) { m = T.sinks[u.h] * LOG2E; lpart = (lh == 0) ? 1.f : 0.f; }
    else { m = -1e30f; lpart = 0.f; }
    f32x16 o[2];
#pragma unroll
    for (int r = 0; r < 16; ++r) { o[0][r] = 0.f; o[1][r] = 0.f; }
    const int kb0 = 256 * g.n - 128 + 32 * wave;
    tile_step<true>(lds, 32 * (wave + 4), 4, qf, cst, sl2, g.maxs, qi, lh, lane, m, lpart, o);
    if (kb0 + 96 >= 0) tile_step<false>(lds, 32 * (wave + 3), 3, qf, cst, sl2, g.maxs, qi, lh, lane, m, lpart, o);
    if (kb0 + 64 >= 0) tile_step<false>(lds, 32 * (wave + 2), 2, qf, cst, sl2, g.maxs, qi, lh, lane, m, lpart, o);
    if (kb0 + 32 >= 0) tile_step<false>(lds, 32 * (wave + 1), 1, qf, cst, sl2, g.maxs, qi, lh, lane, m, lpart, o);
    if (kb0 >= 0)      tile_step<true>(lds, 32 * wave, 0, qf, cst, sl2, g.maxs, qi, lh, lane, m, lpart, o);
    float l;
    { auto rr = __builtin_amdgcn_permlane32_swap(__float_as_uint(lpart), __float_as_uint(lpart), false, false); l = __uint_as_float(rr[0]) + __uint_as_float(rr[1]); }
    const float inv = 1.0f / l;
    if (u.kind != 0 && lh == 0) T.lse[((size_t)(u.kind - 1) * MROWS + qrow) * NH + u.h] = m + log2f(l);
    bf16_t* op = T.oall + qrow * 4096 + g.ocol + 4 * lh;
#pragma unroll
    for (int d0 = 0; d0 < 2; ++d0)
#pragma unroll
        for (int q4 = 0; q4 < 4; ++q4) { u32x2 w; w.x = cvtpk(o[d0][4 * q4 + 0] * inv, o[d0][4 * q4 + 1] * inv); w.y = cvtpk(o[d0][4 * q4 + 2] * inv, o[d0][4 * q4 + 3] * inv);
            *(u32x2*)(op + 32 * d0 + 8 * q4) = w; }
}
__device__ __forceinline__ void phase(ATT_LAS unsigned char* lds, const Tensors& T, int vcu, int G, int tid, int wave, int lane) {
    Unit cur, nxt; Stage st;
    if (!next_unit(0, vcu, G, cur)) return;
    stage_load(st, T, cur, tid);
    for (int i = 0;; ++i) {
        __syncthreads();
        stage_write(st, lds, tid);
        __syncthreads();
        const bool has_next = next_unit(i + 1, vcu, G, nxt);
        if (has_next) stage_load(st, T, nxt, tid);
        unit_compute(lds, T, cur, wave, lane);
        if (!has_next) break;
        cur = nxt;
    }
    __syncthreads();
}
#undef ATT_LAS
}


constexpr int NWAVES = 8;
constexpr int N_LAUNCHES = MK_N_LAUNCHES;
constexpr int N_PHASES = 9;
constexpr size_t MiB = 1u << 20;
constexpr size_t WS_CTL = 0, CTL_ZERO_BYTES = 1 * MiB;
constexpr size_t WS_WIN = 2 * MiB;
constexpr size_t WS_WOUT = 19 * MiB;
constexpr size_t WS_W1 = 27 * MiB;
constexpr size_t WS_W2 = 59 * MiB;
constexpr size_t WS_LSE = 91 * MiB;
constexpr size_t WS_XN = 97 * MiB;
constexpr size_t WS_PROJ = 225 * MiB;
constexpr size_t WS_OALL = 497 * MiB;
constexpr size_t WS_U = 225 * MiB;
constexpr size_t WS_END = 753 * MiB;
static_assert(WS_WIN + (size_t)DIN * DM * 2 <= WS_WOUT && WS_WOUT + (size_t)DM * DM * 2 <= WS_W1 && WS_W1 + (size_t)FF * DM * 2 <= WS_W2 && WS_W2 + (size_t)DM * FF * 2 <= WS_LSE, "weights map");
static_assert(WS_LSE + (size_t)3 * MROWS * 16 * 4 <= WS_XN && WS_XN + (size_t)MROWS * DM * 2 <= WS_PROJ && WS_PROJ + (size_t)MROWS * DIN * 2 <= WS_OALL && WS_OALL + (size_t)MROWS * 4096 * 2 <= WS_END, "activation map");
static_assert(WS_U >= WS_XN + (size_t)MROWS * DM * 2 && WS_U + (size_t)MROWS * FF * 2 <= WS_END, "u overlay");
constexpr int CW_BAR = 4096;
constexpr int RING_OFF = 0, RING_BYTES = 131072;
constexpr int LDSCTL_OFF = RING_BYTES, MISC_OFF = LDSCTL_OFF + 320;
constexpr int LDS_BYTES = 147456;
static_assert(att::LDS_BYTES <= RING_BYTES && MISC_OFF + 128 <= LDS_BYTES, "LDS map");

#define GAS __attribute__((address_space(1)))
#define LAS __attribute__((address_space(3)))
typedef unsigned short bf16;
typedef unsigned v4u __attribute__((ext_vector_type(4)));
typedef float f32x4 __attribute__((ext_vector_type(4)));
typedef short bf16x8 __attribute__((ext_vector_type(8)));
typedef GAS unsigned gu32;
typedef GAS unsigned long long gu64;
#define RLX_AGENT __ATOMIC_RELAXED, __HIP_MEMORY_SCOPE_AGENT
#define LDS_WAIT() asm volatile("s_waitcnt lgkmcnt(0)" ::: "memory")
#define VM_WAIT() asm volatile("s_waitcnt vmcnt(0)" ::: "memory")
__device__ __forceinline__ unsigned long long rt() { return __builtin_amdgcn_s_memrealtime(); }
__device__ __forceinline__ unsigned f2bf(float f) { unsigned u = __builtin_bit_cast(unsigned, f); return (u + 0x7fffu + ((u >> 16) & 1u)) >> 16; }
__device__ __forceinline__ unsigned pk2(float lo, float hi) { return f2bf(lo) | (f2bf(hi) << 16); }

#define XB_TMO      128
#define XB_XCNT(j)  (256  + 64 * (j))
#define XB_XSUB(j)  (1280 + 64 * (j))
#define XB_XGEN(j)  (2304 + 64 * (j))
#define XB_TOP      3328
#define XB_TOPGEN   3392
#define XCD_BAR_WORDS 3456
#define XB_SPIN_CAP (1u << 18)

__device__ __forceinline__ unsigned xb_ld(unsigned* p)              { return __hip_atomic_load(p, __ATOMIC_RELAXED, __HIP_MEMORY_SCOPE_AGENT); }
__device__ __forceinline__ unsigned xb_add(unsigned* p, unsigned v) { return __hip_atomic_fetch_add(p, v, __ATOMIC_RELAXED, __HIP_MEMORY_SCOPE_AGENT); }
__device__ __forceinline__ unsigned xb_xcc_id() { return (unsigned)__builtin_amdgcn_s_getreg((3 << 11) | 20) & 0xFu; }
#define XB_SPIN(cond, bar) do { unsigned _sp = 0; while (cond) { __builtin_amdgcn_s_sleep(1); \
    if ((++_sp & 255u) == 0u) { if (xb_ld(&(bar)[XB_TMO])) break; if (_sp > XB_SPIN_CAP) { atomicAdd(&(bar)[XB_TMO], 1u); break; } } } } while (0)

struct XcdBarrier {
    unsigned* bar; unsigned x;
    volatile LAS unsigned* st;
};

__device__ __forceinline__ XcdBarrier xcd_barrier_post(unsigned* bar, volatile LAS unsigned* st) {
    XcdBarrier b; b.bar = bar; b.x = xb_xcc_id(); b.st = st;
    if (threadIdx.x == 0) (void)xb_add(&bar[XB_XCNT(b.x)], 1u);
    return b;
}
__device__ __forceinline__ void xcd_barrier_complete(unsigned* bar, unsigned x, unsigned& nloc, unsigned& nx) {
    const unsigned G = gridDim.x * gridDim.y * gridDim.z;
    unsigned sum, cnt, mine, sp = 0u;
    for (;;) {
        sum = 0u; cnt = 0u; mine = 0u;
#pragma unroll
        for (unsigned j = 0; j < 16; ++j) { const unsigned c = xb_ld(&bar[XB_XCNT(j)]); sum += c; cnt += (c > 0u) ? 1u : 0u; mine = (j == x) ? c : mine; }
        if (sum == G) break;
        __builtin_amdgcn_s_sleep(1);
        if ((++sp & 255u) == 0u) { if (xb_ld(&bar[XB_TMO])) break; if (sp > XB_SPIN_CAP) { atomicAdd(&bar[XB_TMO], 1u); break; } }
    }
    nloc = mine > 0u ? mine : 1u; nx = cnt > 0u ? cnt : 1u;
}

__device__ __forceinline__ void xcd_barrier(const XcdBarrier& b) {
    asm volatile("s_waitcnt vmcnt(0)" ::: "memory");
    __syncthreads();
    if (threadIdx.x == 0) {
        unsigned* bar = b.bar;
        __builtin_amdgcn_s_waitcnt(0);
        unsigned nloc = b.st[0], nx = b.st[1];
        if (nloc == 0u) { xcd_barrier_complete(bar, b.x, nloc, nx); b.st[0] = nloc; b.st[1] = nx; }
        const unsigned old = xb_add(&bar[XB_XSUB(b.x)], 1u);
        const unsigned gen = old / nloc;
        if (old + 1u == (gen + 1u) * nloc) {
            __builtin_amdgcn_fence(__ATOMIC_RELEASE, "agent");
            asm volatile("s_waitcnt vmcnt(0)" ::: "memory");
            const unsigned og = xb_add(&bar[XB_TOP], 1u);
            const unsigned tg = og / nx;
            if (og + 1u == (tg + 1u) * nx) xb_add(&bar[XB_TOPGEN], 1u);
            else XB_SPIN(xb_ld(&bar[XB_TOPGEN]) == tg, bar);
            __builtin_amdgcn_fence(__ATOMIC_ACQUIRE, "agent");
            xb_add(&bar[XB_XGEN(b.x)], 1u);
            asm volatile("s_waitcnt vmcnt(0)" ::: "memory");
        } else {
            XB_SPIN(xb_ld(&bar[XB_XGEN(b.x)]) == gen, bar);
            __builtin_amdgcn_fence(__ATOMIC_ACQUIRE, "agent");
            asm volatile("s_waitcnt vmcnt(0)" ::: "memory");
        }
    }
    __syncthreads();
}

__device__ __forceinline__ float wave_sum(float v) {
#pragma unroll
    for (int o = 1; o < 64; o <<= 1) v += __shfl_xor(v, o);
    return v;
}
__device__ __forceinline__ void p0_transpose_item(const float* W, int K, int N, bf16* WT, LAS float* scr, int item, int lane) {
    const int nblk = N / 32, kb = item / nblk, nb = item % nblk, k0 = 64 * kb, n0 = 32 * nb;
#pragma unroll 8
    for (int i = 0; i < 32; ++i) { const int kk = 2 * i + (lane >> 5); scr[kk * 33 + (lane & 31)] = W[(size_t)(k0 + kk) * N + n0 + (lane & 31)]; }
    LDS_WAIT(); asm volatile("" ::: "memory");
    const int c = lane & 7;
#pragma unroll
    for (int j = 0; j < 4; ++j) { const int n = (lane >> 3) + 8 * j; const LAS float* s = scr + (8 * c) * 33 + n;
        v4u o; o.x = pk2(s[0 * 33], s[1 * 33]); o.y = pk2(s[2 * 33], s[3 * 33]); o.z = pk2(s[4 * 33], s[5 * 33]); o.w = pk2(s[6 * 33], s[7 * 33]);
        *(GAS v4u*)(WT + (size_t)(n0 + n) * K + k0 + 8 * c) = o; }
    LDS_WAIT(); asm volatile("" ::: "memory");
}
__device__ __forceinline__ void rms_row_to_bf16(const float* xrow, const float* g, bf16* orow, int lane) {
    const GAS f32x4* xr = (const GAS f32x4*)xrow + lane; const GAS f32x4* gr = (const GAS f32x4*)g + lane;
    f32x4 v[8]; float s = 0.f;
#pragma unroll
    for (int j = 0; j < 8; ++j) { v[j] = xr[64 * j]; s += (v[j].x * v[j].x + v[j].y * v[j].y) + (v[j].z * v[j].z + v[j].w * v[j].w); }
    const float rstd = 1.0f / sqrtf(wave_sum(s) * (1.f / DM) + RMS_EPS);
    GAS unsigned long long* o8 = (GAS unsigned long long*)orow + lane;
#pragma unroll
    for (int j = 0; j < 8; ++j) { const f32x4 gg = gr[64 * j]; const f32x4 y = (v[j] * rstd) * gg;
        o8[64 * j] = (unsigned long long)pk2(y.x, y.y) | ((unsigned long long)pk2(y.z, y.w) << 32); }
}
__device__ __forceinline__ void rms_row_inplace(float* xrow, const float* g, int lane) {
    GAS f32x4* xr = (GAS f32x4*)xrow + lane; const GAS f32x4* gr = (const GAS f32x4*)g + lane;
    f32x4 v[8]; float s = 0.f;
#pragma unroll
    for (int j = 0; j < 8; ++j) { v[j] = xr[64 * j]; s += (v[j].x * v[j].x + v[j].y * v[j].y) + (v[j].z * v[j].z + v[j].w * v[j].w); }
    const float rstd = 1.0f / sqrtf(wave_sum(s) * (1.f / DM) + RMS_EPS);
#pragma unroll
    for (int j = 0; j < 8; ++j) { const f32x4 gg = gr[64 * j]; xr[64 * j] = (v[j] * rstd) * gg; }
}
__device__ __forceinline__ float bf_lo(unsigned w) { return __uint_as_float(w << 16); }
__device__ __forceinline__ float bf_hi(unsigned w) { return __uint_as_float(w & 0xffff0000u); }
__device__ __forceinline__ void combine_row(const bf16* orow  , const float* lse  , const float* ga, const float* gb, bf16* mrow  , int lane) {
    const GAS v4u* o4 = (const GAS v4u*)orow + 2 * lane;
    v4u ra[2], rb[3][2];
#pragma unroll
    for (int q = 0; q < 2; ++q) { ra[q] = o4[q]; rb[0][q] = o4[128 + q]; rb[1][q] = o4[256 + q]; rb[2][q] = o4[384 + q]; }
    const int head = lane >> 2;
    float l0 = lse[head], l1 = lse[(size_t)MROWS * 16 + head], l2 = lse[(size_t)2 * MROWS * 16 + head];
    const float lm = fmaxf(l0, fmaxf(l1, l2));
    float w0 = exp2f(l0 - lm), w1 = exp2f(l1 - lm), w2 = exp2f(l2 - lm);
    const float wi = 1.0f / (w0 + w1 + w2); w0 *= wi; w1 *= wi; w2 *= wi;
    float a[16], b[16]; float sa = 0.f, sb = 0.f;
#pragma unroll
    for (int q = 0; q < 2; ++q)
#pragma unroll
        for (int e = 0; e < 4; ++e) {
            const unsigned wa = ra[q][e], x0 = rb[0][q][e], x1 = rb[1][q][e], x2 = rb[2][q][e];
            const int i = q * 8 + e * 2;
            a[i] = bf_lo(wa); a[i + 1] = bf_hi(wa);
            b[i] = w0 * bf_lo(x0) + w1 * bf_lo(x1) + w2 * bf_lo(x2);
            b[i + 1] = w0 * bf_hi(x0) + w1 * bf_hi(x1) + w2 * bf_hi(x2);
            sa += a[i] * a[i] + a[i + 1] * a[i + 1]; sb += b[i] * b[i] + b[i + 1] * b[i + 1];
        }
    const float ra_ = 1.0f / sqrtf(wave_sum(sa) * (1.f / 1024.f) + RMS_EPS), rb_ = 1.0f / sqrtf(wave_sum(sb) * (1.f / 1024.f) + RMS_EPS);
    const GAS f32x4* ga4 = (const GAS f32x4*)ga + 4 * lane; const GAS f32x4* gb4 = (const GAS f32x4*)gb + 4 * lane;
    GAS v4u* m4 = (GAS v4u*)mrow + 2 * lane;
#pragma unroll
    for (int q = 0; q < 2; ++q) {
        const f32x4 g0 = ga4[2 * q], g1 = ga4[2 * q + 1], h0 = gb4[2 * q], h1 = gb4[2 * q + 1];
        v4u wa, wb; const int i = q * 8;
        wa.x = pk2(a[i + 0] * ra_ * g0.x, a[i + 1] * ra_ * g0.y); wa.y = pk2(a[i + 2] * ra_ * g0.z, a[i + 3] * ra_ * g0.w);
        wa.z = pk2(a[i + 4] * ra_ * g1.x, a[i + 5] * ra_ * g1.y); wa.w = pk2(a[i + 6] * ra_ * g1.z, a[i + 7] * ra_ * g1.w);
        wb.x = pk2(b[i + 0] * rb_ * h0.x, b[i + 1] * rb_ * h0.y); wb.y = pk2(b[i + 2] * rb_ * h0.z, b[i + 3] * rb_ * h0.w);
        wb.z = pk2(b[i + 4] * rb_ * h1.x, b[i + 5] * rb_ * h1.y); wb.w = pk2(b[i + 6] * rb_ * h1.z, b[i + 7] * rb_ * h1.w);
        m4[q] = wa; m4[128 + q] = wb;
    }
}

struct Args { const float* in[12]; float* out; unsigned char* ws; int ph_lo, ph_hi; };
__global__ void __launch_bounds__(NWAVES * 64, 2) block_fwd(Args args) {
    extern __shared__ __attribute__((aligned(16))) unsigned char lds_raw[];
    LAS unsigned char* lds = (LAS unsigned char*)lds_raw;
    volatile LAS unsigned* MISC = (volatile LAS unsigned*)(lds + MISC_OFF);
    const int tid = threadIdx.x, lane = tid & 63, wave = __builtin_amdgcn_readfirstlane(tid >> 6);
    const int G = gridDim.x; const int bx = blockIdx.x;
    const int vcu = (G % 8 == 0) ? (bx % 8) * (G / 8) + bx / 8 : bx;
    unsigned char* ws = args.ws;
    gu32* ctl = (gu32*)(ws + WS_CTL);
    const float* x = args.in[0]; const float* g_attn = args.in[1]; const float* w_in = args.in[2]; const float* b_in = args.in[3]; const float* sinks = args.in[4];
    const float* g_out_a = args.in[5]; const float* g_out_b = args.in[6]; const float* w_out = args.in[7]; const float* g_mlp = args.in[8];
    const float* w_1 = args.in[9]; const float* w_2 = args.in[10]; const float* g_final = args.in[11];
    float* out = args.out;
    bf16* Win_t = (bf16*)(ws + WS_WIN); bf16* Wout_t = (bf16*)(ws + WS_WOUT); bf16* W1_t = (bf16*)(ws + WS_W1); bf16* W2_t = (bf16*)(ws + WS_W2);
    float* LSE = (float*)(ws + WS_LSE); bf16* XN = (bf16*)(ws + WS_XN); bf16* PROJ = (bf16*)(ws + WS_PROJ); bf16* OALL = (bf16*)(ws + WS_OALL); bf16* U = (bf16*)(ws + WS_U);

    for (int u = tid; u < (LDS_BYTES - LDSCTL_OFF) / 4; u += NWAVES * 64) ((LAS unsigned*)(lds + LDSCTL_OFF))[u] = 0u;
    __syncthreads();
    XcdBarrier bar; bar.bar = (unsigned*)(ctl + CW_BAR); bar.x = 0; bar.st = nullptr;
    if (N_LAUNCHES == 1) bar = xcd_barrier_post((unsigned*)(ctl + CW_BAR), MISC + 8);
    const int lo = args.ph_lo, hi = args.ph_hi;
#define IN(k) (lo <= (k) && (k) < hi)
#define GRID_BAR(k) do { if (IN(k) && IN((k) + 1)) xcd_barrier(bar); } while (0)
    const int gw = vcu * NWAVES + wave, NGW = G * NWAVES;

    if (IN(0)) {
        LAS float* scr = (LAS float*)(lds + RING_OFF + wave * 16384);
        constexpr int I_IN = (DM / 64) * (DIN / 32), I_OUT = (DM / 64) * (DM / 32), I_1 = (DM / 64) * (FF / 32), I_2 = (FF / 64) * (DM / 32);
        constexpr int NITEMS = I_IN + I_OUT + I_1 + I_2;
        for (int it = gw; it < NITEMS; it += NGW) {
            int r = it;
            if (r < I_IN) { p0_transpose_item(w_in, DM, DIN, Win_t, scr, r, lane); continue; } r -= I_IN;
            if (r < I_OUT) { p0_transpose_item(w_out, DM, DM, Wout_t, scr, r, lane); continue; } r -= I_OUT;
            if (r < I_1) { p0_transpose_item(w_1, DM, FF, W1_t, scr, r, lane); continue; } r -= I_1;
            p0_transpose_item(w_2, FF, DM, W2_t, scr, r, lane);
        }
        for (int m = gw; m < MROWS; m += NGW) rms_row_to_bf16(x + (size_t)m * DM, g_attn, XN + (size_t)m * DM, lane);
    }
    GRID_BAR(0);
    if (IN(1)) {
        pg8::Gemm g{XN, Win_t, MROWS, DIN, DM}; pg8::StaticOrder S; S.init(MROWS, DIN, G, bx);
        pg8::EpiProj E{PROJ, DIN, b_in, QSCALE};
        pg8::gemm_phase<pg8::EpiProj, pg8::StaticOrder, true, true>(lds + RING_OFF, g, S, E);
    }
    GRID_BAR(1);
    if (IN(2)) {
        const att::Tensors T{PROJ, OALL, LSE, sinks};
        att::phase(lds + RING_OFF, T, vcu, G, tid, wave, lane);
    }
    GRID_BAR(2);
    if (IN(3)) {
        for (int m = gw; m < MROWS; m += NGW) combine_row(OALL + (size_t)m * 4096, LSE + (size_t)m * 16, g_out_a, g_out_b, XN + (size_t)m * DM, lane);
    }
    GRID_BAR(3);
    if (IN(4)) {
        pg8::Gemm g{XN, Wout_t, MROWS, DM, DM}; pg8::StaticOrder S; S.init(MROWS, DM, G, bx);
        pg8::EpiResF32 E{x, out, DM};
        pg8::gemm_phase<pg8::EpiResF32, pg8::StaticOrder, true, true>(lds + RING_OFF, g, S, E);
    }
    GRID_BAR(4);
    if (IN(5)) {
        for (int m = gw; m < MROWS; m += NGW) rms_row_to_bf16(out + (size_t)m * DM, g_mlp, XN + (size_t)m * DM, lane);
    }
    GRID_BAR(5);
    if (IN(6)) {
        pg8::Gemm g{XN, W1_t, MROWS, FF, DM}; pg8::StaticOrder S; S.init(MROWS, FF, G, bx);
        pg8::EpiRelu2 E{U, FF};
        pg8::gemm_phase<pg8::EpiRelu2, pg8::StaticOrder, true, true>(lds + RING_OFF, g, S, E);
    }
    GRID_BAR(6);
    if (IN(7)) {
        pg8::Gemm g{U, W2_t, MROWS, DM, FF}; pg8::StaticOrder S; S.init(MROWS, DM, G, bx);
        pg8::EpiResF32 E{out, out, DM};
        pg8::gemm_phase<pg8::EpiResF32, pg8::StaticOrder, true, true>(lds + RING_OFF, g, S, E);
    }
    GRID_BAR(7);
    if (IN(8)) {
        for (int m = gw; m < MROWS; m += NGW) rms_row_inplace(out + (size_t)m * DM, g_final, lane);
    }
#undef IN
#undef GRID_BAR
}

extern "C" void kernel_launch(void* const* d_in, const int* in_sizes, int n_in, void* d_out, int out_size, void* d_ws, size_t ws_size, hipStream_t stream) {
    static int grid = 0;
    if (grid == 0) {
        if (n_in != 12 || in_sizes[0] != MROWS * DM || out_size != MROWS * DM || ws_size < WS_END) {
            fprintf(stderr, "kernel_launch: built for 12 inputs, x/out of %d floats, >= %zu bytes of workspace; got n_in %d, in0 %d, out %d, ws %zu; nothing launched\n", MROWS * DM, (size_t)WS_END, n_in, n_in > 0 ? in_sizes[0] : -1, out_size, ws_size); grid = -1; return; }
        int dev = 0, cus = 0, per_cu = 0;
        if (hipGetDevice(&dev) != hipSuccess || hipDeviceGetAttribute(&cus, hipDeviceAttributeMultiprocessorCount, dev) != hipSuccess) { fprintf(stderr, "kernel_launch: device query failed\n"); grid = -1; return; }
        if (hipFuncSetAttribute((const void*)block_fwd, hipFuncAttributeMaxDynamicSharedMemorySize, LDS_BYTES) != hipSuccess) { fprintf(stderr, "kernel_launch: hipFuncSetAttribute failed\n"); grid = -1; return; }
        if (hipOccupancyMaxActiveBlocksPerMultiprocessor(&per_cu, (const void*)block_fwd, NWAVES * 64, LDS_BYTES) != hipSuccess || per_cu < 1)
            fprintf(stderr, "kernel_launch: note: occupancy query reports %d workgroups per CU\n", per_cu);
        (void)hipGetLastError();
        grid = cus;
    }
    if (grid < 0) return;
    if (hipMemsetAsync((char*)d_ws + WS_CTL, 0, CTL_ZERO_BYTES, stream) != hipSuccess) { fprintf(stderr, "kernel_launch: memset failed\n"); return; }
    Args a{};
    for (int i = 0; i < 12; ++i) a.in[i] = (const float*)d_in[i];
    a.out = (float*)d_out; a.ws = (unsigned char*)d_ws;
    if (N_LAUNCHES == 1) { a.ph_lo = 0; a.ph_hi = N_PHASES; hipLaunchKernelGGL(block_fwd, dim3(grid), dim3(NWAVES * 64), LDS_BYTES, stream, a); }
    else for (int li = 0; li < N_PHASES; ++li) { a.ph_lo = li; a.ph_hi = li + 1; hipLaunchKernelGGL(block_fwd, dim3(grid), dim3(NWAVES * 64), LDS_BYTES, stream, a); }
    const hipError_t le = hipPeekAtLastError();
    if (le != hipSuccess) fprintf(stderr, "kernel_launch: launch failed: %s\n", hipGetErrorName(le));
}
```

```cpp
#include <hip/hip_runtime.h>
#include <hip/hip_bf16.h>
#include <cstdio>
#include <cstdint>

#ifndef MK_N_LAUNCHES
#define MK_N_LAUNCHES 1
#endif

constexpr int BATCH = 4, SEQ = 8192, DM = 2048, DIN = 4352, FF = 8192, NH = 16, HD = 64;
constexpr int MROWS = BATCH * SEQ;
constexpr int QA_OFF = 0, KA_OFF = 1024, VA_OFF = 1152, QB_OFF = 1280, KB_OFF = 2304, VB_OFF = 3328;
constexpr float RMS_EPS = 1e-5f;
constexpr float LOG2E = 1.4426950408889634f;
constexpr float QSCALE = 0.125f * LOG2E;

namespace pg8 {
#define PG8_LAS __attribute__((address_space(3)))
typedef unsigned short bf16_t;
typedef short bf16x8 __attribute__((ext_vector_type(8)));
typedef float f32x4 __attribute__((ext_vector_type(4)));
typedef unsigned u32x4 __attribute__((ext_vector_type(4)));
constexpr int BM = 256, BK = 64, HALF = 128, HTB = HALF * BK * 2  , STAGE_BYTES = 8 * HTB, NXCD = 8, WGM = 8;

__host__ __device__ __forceinline__ int lds_byte(int r, int c) { const int st = (r >> 4) * 2 + (c >> 5), rr = r & 15, cc = c & 31, ob = rr * 64 + cc * 2; return st * 1024 + (ob ^ (((ob >> 9) & 1) << 5)); }
__host__ __device__ __forceinline__ void stage_rc(int b, int& R, int& C) { const int st = b / 1024, sb = b % 1024, swz = sb ^ (((sb >> 9) & 1) << 5); R = (st >> 1) * 16 + swz / 64; C = (st & 1) * 32 + (swz % 64) / 2; }
__host__ __device__ __forceinline__ int perm32(int rho) { const int n = rho >> 4, i = rho & 15; return 8 * (i >> 2) + 4 * n + (i & 3); }

struct Unit { int pm, pn; };
struct Gemm { const bf16_t* A; const bf16_t* Bt; int M, N, K; };

struct StaticOrder {
    int nM, nN, nwg, G, c;
    __host__ __device__ void init(int M, int N, int G_, int c_) { nM = M / BM; nN = N / BM; nwg = nM * nN; G = G_; c = c_; }
    __host__ __device__ bool next(int i, Unit& u) const {
        const long L = (long)i * G + c; if (L >= nwg) return false;
        int wgid = (int)L; { const int q = nwg / NXCD, r = nwg % NXCD, xcd = wgid % NXCD, off = wgid / NXCD; wgid = (xcd < r ? xcd * (q + 1) : r * (q + 1) + (xcd - r) * q) + off; }
        const int nig = WGM * nN, gid = wgid / nig, fm = gid * WGM, gsz = (nM - fm) < WGM ? (nM - fm) : WGM;
        u.pm = fm + ((wgid % nig) % gsz); u.pn = (wgid % nig) / gsz; return true;
    }
    __device__ __forceinline__ void a_ready(const Unit&) const {}
    __device__ __forceinline__ void done(const Unit&) const {}
};

__device__ __forceinline__ unsigned cvt_pk_bf16(float lo, float hi) { unsigned r; asm volatile("v_cvt_pk_bf16_f32 %0, %1, %2" : "=v"(r) : "v"(lo), "v"(hi)); return r; }

struct EpiProj {
    static constexpr bool PERM = true, AFTER_DRAIN = false;
    bf16_t* O; int ldc; const float* bias; float qscale;
    __device__ __forceinline__ void operator()(const f32x4 (&acc)[2][2][4][2], const Unit& u, int wr, int wc, int fr, int fq) const {
        const int row0 = u.pm * BM + wr * 64 + fr;
        const float sc = (u.pn < 4 || (u.pn >= 5 && u.pn < 9)) ? qscale : 1.f;
        const int col0 = u.pn * BM + wc * 32 + 8 * fq;
        f32x4 bv[2][2];
#pragma unroll
        for (int bj = 0; bj < 2; ++bj)
#pragma unroll
            for (int n = 0; n < 2; ++n) bv[bj][n] = *(const f32x4*)(bias + col0 + bj * HALF + 4 * n);
#pragma unroll
        for (int ai = 0; ai < 2; ++ai)
#pragma unroll
            for (int m = 0; m < 4; ++m) { bf16_t* rowp = O + (size_t)(row0 + ai * HALF + m * 16) * ldc + col0;
#pragma unroll
                for (int bj = 0; bj < 2; ++bj) { f32x4 v0 = (acc[ai][bj][m][0] + bv[bj][0]) * sc, v1 = (acc[ai][bj][m][1] + bv[bj][1]) * sc;
                    u32x4 w; w.x = cvt_pk_bf16(v0[0], v0[1]); w.y = cvt_pk_bf16(v0[2], v0[3]); w.z = cvt_pk_bf16(v1[0], v1[1]); w.w = cvt_pk_bf16(v1[2], v1[3]);
                    *(u32x4*)(rowp + bj * HALF) = w; } }
    }
};
struct EpiRelu2 {
    static constexpr bool PERM = true, AFTER_DRAIN = false;
    bf16_t* O; int ldc;
    __device__ __forceinline__ void operator()(const f32x4 (&acc)[2][2][4][2], const Unit& u, int wr, int wc, int fr, int fq) const {
        const int row0 = u.pm * BM + wr * 64 + fr;
        const int col0 = u.pn * BM + wc * 32 + 8 * fq;
#pragma unroll
        for (int ai = 0; ai < 2; ++ai)
#pragma unroll
            for (int m = 0; m < 4; ++m) { bf16_t* rowp = O + (size_t)(row0 + ai * HALF + m * 16) * ldc + col0;
#pragma unroll
                for (int bj = 0; bj < 2; ++bj) { f32x4 v0 = acc[ai][bj][m][0], v1 = acc[ai][bj][m][1];
#pragma unroll
                    for (int e = 0; e < 4; ++e) { const float a = fmaxf(v0[e], 0.f), b = fmaxf(v1[e], 0.f); v0[e] = a * a; v1[e] = b * b; }
                    u32x4 w; w.x = cvt_pk_bf16(v0[0], v0[1]); w.y = cvt_pk_bf16(v0[2], v0[3]); w.z = cvt_pk_bf16(v1[0], v1[1]); w.w = cvt_pk_bf16(v1[2], v1[3]);
                    *(u32x4*)(rowp + bj * HALF) = w; } }
    }
};
struct EpiResF32 {
    static constexpr bool PERM = false, AFTER_DRAIN = false;
    const float* base; float* out; int ldc;
    __device__ __forceinline__ void operator()(const f32x4 (&acc)[2][2][4][2], const Unit& u, int wr, int wc, int fr, int fq) const {
        const int row0 = u.pm * BM + wr * 64 + fr, col0 = u.pn * BM + wc * 32 + 4 * fq;
#pragma unroll
        for (int ai = 0; ai < 2; ++ai)
#pragma unroll
            for (int m = 0; m < 4; ++m) { const size_t off = (size_t)(row0 + ai * HALF + m * 16) * ldc + col0;
                f32x4 bs[2][2];
#pragma unroll
                for (int bj = 0; bj < 2; ++bj)
#pragma unroll
                    for (int n = 0; n < 2; ++n) bs[bj][n] = *(const f32x4*)(base + off + bj * HALF + n * 16);
#pragma unroll
                for (int bj = 0; bj < 2; ++bj)
#pragma unroll
                    for (int n = 0; n < 2; ++n) *(f32x4*)(out + off + bj * HALF + n * 16) = bs[bj][n] + acc[ai][bj][m][n];
                if (m & 1) asm volatile("" ::: "memory"); }
    }
};
struct EpiResF32Bf {
    static constexpr bool PERM = false, AFTER_DRAIN = false;
    const float* base; float* out; bf16_t* xb; float* ssq; int ldc;
    __device__ __forceinline__ void operator()(const f32x4 (&acc)[2][2][4][2], const Unit& u, int wr, int wc, int fr, int fq) const {
        typedef unsigned u32x2 __attribute__((ext_vector_type(2)));
        const int row0 = u.pm * BM + wr * 64 + fr, col0 = u.pn * BM + wc * 32 + 4 * fq;
#pragma unroll
        for (int ai = 0; ai < 2; ++ai)
#pragma unroll
            for (int m = 0; m < 4; ++m) { const int row = row0 + ai * HALF + m * 16; const size_t off = (size_t)row * ldc + col0;
                f32x4 bs[2][2];
#pragma unroll
                for (int bj = 0; bj < 2; ++bj)
#pragma unroll
                    for (int n = 0; n < 2; ++n) bs[bj][n] = *(const f32x4*)(base + off + bj * HALF + n * 16);
                float s = 0.f;
#pragma unroll
                for (int bj = 0; bj < 2; ++bj)
#pragma unroll
                    for (int n = 0; n < 2; ++n) { const f32x4 v = bs[bj][n] + acc[ai][bj][m][n]; *(f32x4*)(out + off + bj * HALF + n * 16) = v;
                        u32x2 w; w.x = cvt_pk_bf16(v[0], v[1]); w.y = cvt_pk_bf16(v[2], v[3]); *(u32x2*)(xb + off + bj * HALF + n * 16) = w;
                        s += (v[0] * v[0] + v[1] * v[1]) + (v[2] * v[2] + v[3] * v[3]); }
                s += __shfl_xor(s, 16); s += __shfl_xor(s, 32);
                if (fq == 0) atomicAdd(ssq + row, s);
                if (m & 1) asm volatile("" ::: "memory"); }
    }
};
struct EpiRelu2S {
    static constexpr bool PERM = true, AFTER_DRAIN = false;
    bf16_t* O; int ldc; const float* ssq; float inv_k, eps;
    __device__ __forceinline__ void operator()(const f32x4 (&acc)[2][2][4][2], const Unit& u, int wr, int wc, int fr, int fq) const {
        const int row0 = u.pm * BM + wr * 64 + fr;
        const int col0 = u.pn * BM + wc * 32 + 8 * fq;
        float rs[2][4];
#pragma unroll
        for (int ai = 0; ai < 2; ++ai)
#pragma unroll
            for (int m = 0; m < 4; ++m) rs[ai][m] = 1.0f / (ssq[row0 + ai * HALF + m * 16] * inv_k + eps);
#pragma unroll
        for (int ai = 0; ai < 2; ++ai)
#pragma unroll
            for (int m = 0; m < 4; ++m) { bf16_t* rowp = O + (size_t)(row0 + ai * HALF + m * 16) * ldc + col0; const float r2 = rs[ai][m];
#pragma unroll
                for (int bj = 0; bj < 2; ++bj) { f32x4 v0 = acc[ai][bj][m][0], v1 = acc[ai][bj][m][1];
#pragma unroll
                    for (int e = 0; e < 4; ++e) { const float a = fmaxf(v0[e], 0.f), b = fmaxf(v1[e], 0.f); v0[e] = a * a * r2; v1[e] = b * b * r2; }
                    u32x4 w; w.x = cvt_pk_bf16(v0[0], v0[1]); w.y = cvt_pk_bf16(v0[2], v0[3]); w.z = cvt_pk_bf16(v1[0], v1[1]); w.w = cvt_pk_bf16(v1[2], v1[3]);
                    *(u32x4*)(rowp + bj * HALF) = w; } }
    }
};

template <class Epi, class Sched, bool ALIGN_EPI = false, bool SP2 = false>
__device__ __forceinline__ void gemm_phase(PG8_LAS unsigned char* lds, const Gemm g, const Sched& S, const Epi& E) {
    const int tid = threadIdx.x, wid = __builtin_amdgcn_readfirstlane(tid >> 6), lane = tid & 63, wr = wid >> 2, wc = wid & 3, fr = lane & 15, fq = lane >> 4;
    const int K = g.K, nt = K / BK;
    unsigned voffA[2], voffB[2];
#pragma unroll
    for (int i = 0; i < 2; ++i) { int R, C; stage_rc(tid * 16 + i * 8192, R, C); const int Rb = Epi::PERM ? ((R & ~31) + perm32(R & 31)) : R;
        voffA[i] = (unsigned)(R * K + C) * 2u; voffB[i] = (unsigned)(Rb * K + C) * 2u; }
    const size_t kstep = (size_t)(BK * 2);
    const size_t hstep = (size_t)HALF * K * 2;
    const size_t tstep = 2 * hstep;
    const unsigned ldsw = (unsigned)wid * 1024u;
    const int aoff = lds_byte(wr * 64 + fr, fq * 8), boff = lds_byte(wc * 32 + fr, fq * 8);
#define PG8_SA(b, h) (((b) * 2 + (h)) * HTB)
#define PG8_SB(b, h) ((4 + (b) * 2 + (h)) * HTB)
#define PG8_STAGE(bufoff, gbase, voff) do { _Pragma("unroll") for (int _i = 0; _i < 2; ++_i) \
        __builtin_amdgcn_global_load_lds((const unsigned*)((const char*)(gbase) + (voff)[_i]), (PG8_LAS unsigned*)(lds + (bufoff) + ldsw + _i * 8192), 16, 0, 0); } while (0)
#define PG8_LDA(dst, b, h) do { _Pragma("unroll") for (int m = 0; m < 4; ++m) _Pragma("unroll") for (int k = 0; k < 2; ++k) dst[m][k] = *(const PG8_LAS bf16x8*)(lds + PG8_SA(b, h) + aoff + m * 2048 + k * 1024); } while (0)
#define PG8_LDB(dst, b, h) do { _Pragma("unroll") for (int n = 0; n < 2; ++n) _Pragma("unroll") for (int k = 0; k < 2; ++k) dst[n][k] = *(const PG8_LAS bf16x8*)(lds + PG8_SB(b, h) + boff + n * 2048 + k * 1024); } while (0)
#define PG8_MMA(ai, bj, At, Bt) do { __builtin_amdgcn_s_setprio(1); _Pragma("unroll") for (int m = 0; m < 4; ++m) _Pragma("unroll") for (int n = 0; n < 2; ++n) _Pragma("unroll") for (int k = 0; k < 2; ++k) \
        acc[ai][bj][m][n] = __builtin_amdgcn_mfma_f32_16x16x32_bf16(Bt[n][k], At[m][k], acc[ai][bj][m][n], 0, 0, 0); __builtin_amdgcn_s_setprio(0); } while (0)
#define PG8_WAIT_V(n) asm volatile("s_waitcnt vmcnt(" #n ")" ::: "memory")
#define PG8_WAIT_L(n) asm volatile("s_waitcnt lgkmcnt(" #n ")" ::: "memory")
#define PG8_BAR __builtin_amdgcn_s_barrier()
#define PG8_SCHED __builtin_amdgcn_sched_barrier(0)
    Unit cur, nxt; int ui = 0;
    if (!S.next(0, cur)) return;
    f32x4 acc[2][2][4][2];
#pragma unroll
    for (int a = 0; a < 2; ++a)
#pragma unroll
        for (int b = 0; b < 2; ++b)
#pragma unroll
            for (int m = 0; m < 4; ++m)
#pragma unroll
                for (int n = 0; n < 2; ++n) acc[a][b][m][n] = (f32x4){0.f, 0.f, 0.f, 0.f};
    bf16x8 At[4][2], B0[2][2], B1[2][2];
    const char* cA = (const char*)g.A + (size_t)cur.pm * tstep; const char* cB = (const char*)g.Bt + (size_t)cur.pn * tstep;
    S.a_ready(cur);
    if constexpr (SP2) {
        PG8_STAGE(PG8_SB(0, 0), cB, voffB); PG8_STAGE(PG8_SB(0, 1), cB + hstep, voffB); PG8_STAGE(PG8_SA(0, 0), cA, voffA); PG8_STAGE(PG8_SA(0, 1), cA + hstep, voffA);
        if (wr == 1) PG8_BAR;
        PG8_WAIT_V(2); PG8_BAR;
        PG8_STAGE(PG8_SB(1, 0), cB + kstep, voffB); PG8_STAGE(PG8_SA(1, 0), cA + kstep, voffA); PG8_STAGE(PG8_SB(1, 1), cB + hstep + kstep, voffB);
        PG8_WAIT_V(6); PG8_BAR;
    } else {
        PG8_STAGE(PG8_SB(0, 0), cB, voffB); PG8_STAGE(PG8_SA(0, 0), cA, voffA); PG8_STAGE(PG8_SB(0, 1), cB + hstep, voffB); PG8_STAGE(PG8_SA(0, 1), cA + hstep, voffA);
        if (wr == 1) PG8_BAR;
        PG8_WAIT_V(4); PG8_BAR;
        PG8_STAGE(PG8_SB(1, 0), cB + kstep, voffB); PG8_STAGE(PG8_SA(1, 0), cA + kstep, voffA); PG8_STAGE(PG8_SB(1, 1), cB + hstep + kstep, voffB);
        PG8_WAIT_V(6); PG8_BAR;
    }
    for (;;) {
        const bool has_next = S.next(ui + 1, nxt);
        const char* nA = has_next ? (const char*)g.A + (size_t)nxt.pm * tstep : cA; const char* nB = has_next ? (const char*)g.Bt + (size_t)nxt.pn * tstep : cB;
        for (int t = 0; t < nt; t += 2) {
            const bool last = (t == nt - 2);
            const char* a1 = cA + (size_t)(t + 1) * kstep;
            const char* a2 = last ? nA : cA + (size_t)(t + 2) * kstep; const char* b2 = last ? nB : cB + (size_t)(t + 2) * kstep;
            const char* a3 = a2 + kstep; const char* b3 = b2 + kstep;
            if (last && has_next) S.a_ready(nxt);
            if constexpr (SP2) {
            PG8_LDB(B0, 0, 0); PG8_LDB(B1, 0, 1); PG8_SCHED; PG8_LDA(At, 0, 0); PG8_STAGE(PG8_SA(1, 1), a1 + hstep, voffA);
            PG8_WAIT_V(8); PG8_WAIT_L(0); PG8_BAR; PG8_MMA(0, 0, At, B0); PG8_MMA(0, 1, At, B1); PG8_BAR; PG8_SCHED;
            PG8_LDA(At, 0, 1); PG8_STAGE(PG8_SB(0, 0), b2, voffB); PG8_STAGE(PG8_SB(0, 1), b2 + hstep, voffB); PG8_STAGE(PG8_SA(0, 0), a2, voffA);
            PG8_WAIT_V(8); PG8_WAIT_L(0); PG8_BAR; PG8_MMA(1, 0, At, B0); PG8_MMA(1, 1, At, B1); PG8_BAR; PG8_SCHED;
            PG8_LDB(B0, 1, 0); PG8_LDB(B1, 1, 1); PG8_SCHED; PG8_LDA(At, 1, 0); PG8_STAGE(PG8_SA(0, 1), a2 + hstep, voffA);
            PG8_WAIT_V(8); PG8_WAIT_L(0); PG8_BAR; PG8_MMA(0, 0, At, B0); PG8_MMA(0, 1, At, B1); PG8_BAR; PG8_SCHED;
            PG8_LDA(At, 1, 1); PG8_STAGE(PG8_SB(1, 0), b3, voffB); PG8_STAGE(PG8_SB(1, 1), b3 + hstep, voffB); PG8_STAGE(PG8_SA(1, 0), a3, voffA);
            PG8_WAIT_V(8); PG8_WAIT_L(0); PG8_BAR; PG8_MMA(1, 0, At, B0); PG8_MMA(1, 1, At, B1); PG8_BAR; PG8_SCHED;
            } else {
            PG8_LDB(B0, 0, 0); PG8_SCHED; PG8_LDA(At, 0, 0); PG8_STAGE(PG8_SA(1, 1), a1 + hstep, voffA);
            PG8_WAIT_L(8); PG8_BAR; PG8_WAIT_L(0); PG8_MMA(0, 0, At, B0); PG8_BAR; PG8_SCHED;
            PG8_LDB(B1, 0, 1); PG8_STAGE(PG8_SB(0, 0), b2, voffB);
            PG8_BAR; PG8_WAIT_L(0); PG8_MMA(0, 1, At, B1); PG8_BAR;
            PG8_LDA(At, 0, 1); PG8_STAGE(PG8_SA(0, 0), a2, voffA);
            PG8_BAR; PG8_WAIT_L(0); PG8_MMA(1, 0, At, B0); PG8_BAR; PG8_SCHED;
            PG8_STAGE(PG8_SB(0, 1), b2 + hstep, voffB);
            PG8_WAIT_V(6); PG8_BAR; PG8_MMA(1, 1, At, B1); PG8_BAR;
            PG8_LDB(B0, 1, 0); PG8_SCHED; PG8_LDA(At, 1, 0); PG8_STAGE(PG8_SA(0, 1), a2 + hstep, voffA);
            PG8_WAIT_L(8); PG8_BAR; PG8_WAIT_L(0); PG8_MMA(0, 0, At, B0); PG8_BAR; PG8_SCHED;
            PG8_LDB(B1, 1, 1); PG8_STAGE(PG8_SB(1, 0), b3, voffB);
            PG8_BAR; PG8_WAIT_L(0); PG8_MMA(0, 1, At, B1); PG8_BAR;
            PG8_LDA(At, 1, 1); PG8_STAGE(PG8_SA(1, 0), a3, voffA);
            PG8_BAR; PG8_WAIT_L(0); PG8_MMA(1, 0, At, B0); PG8_BAR; PG8_SCHED;
            PG8_STAGE(PG8_SB(1, 1), b3 + hstep, voffB);
            PG8_WAIT_V(6); PG8_BAR; PG8_MMA(1, 1, At, B1); PG8_BAR;
            }
        }
        if constexpr (ALIGN_EPI) { if (wr == 0) PG8_BAR; }
        if constexpr (!Epi::AFTER_DRAIN) { E(acc, cur, wr, wc, fr, fq); S.done(cur); }
        if (!has_next) break;
#pragma unroll
        for (int a = 0; a < 2; ++a)
#pragma unroll
            for (int b = 0; b < 2; ++b)
#pragma unroll
                for (int m = 0; m < 4; ++m)
#pragma unroll
                    for (int n = 0; n < 2; ++n) acc[a][b][m][n] = (f32x4){0.f, 0.f, 0.f, 0.f};
        cur = nxt; cA = nA; cB = nB; ++ui;
        if constexpr (ALIGN_EPI) { if (wr == 1) PG8_BAR; }
    }
    PG8_WAIT_V(0);
    if constexpr (!ALIGN_EPI) { if (wr == 0) PG8_BAR; }
    PG8_BAR;
    if constexpr (Epi::AFTER_DRAIN) { E.fused(acc, cur, wr, wc, fr, fq, lds, wid, lane); S.done(cur); }
#undef PG8_SA
#undef PG8_SB
#undef PG8_STAGE
#undef PG8_LDA
#undef PG8_LDB
#undef PG8_MMA
#undef PG8_WAIT_V
#undef PG8_WAIT_L
#undef PG8_BAR
#undef PG8_SCHED
}
}
namespace att {
#define ATT_LAS __attribute__((address_space(3)))
typedef short bf16x8 __attribute__((ext_vector_type(8)));
typedef short s16x4 __attribute__((ext_vector_type(4)));
typedef float f32x16 __attribute__((ext_vector_type(16)));
typedef unsigned u32x4 __attribute__((ext_vector_type(4)));
typedef unsigned u32x2 __attribute__((ext_vector_type(2)));
typedef unsigned short bf16_t;
constexpr int NKEY = 384;
constexpr int KCH = NKEY * 16 + 16;
constexpr int VH = NKEY * 64 + 64;
constexpr int LDS_K = 0, LDS_V = 8 * KCH, LDS_BYTES = LDS_V + 2 * VH;
constexpr int NUNITS = BATCH * NH * 4 * 32;
struct Tensors { const bf16_t* proj; bf16_t* oall; float* lse; const float* sinks; };
struct Unit { int kind, b, h, blk; };
__device__ __forceinline__ int crow(int r, int lh) { return (r & 3) + 8 * (r >> 2) + 4 * lh; }
__device__ __forceinline__ unsigned cvtpk(float lo, float hi) { unsigned r; asm("v_cvt_pk_bf16_f32 %0, %1, %2" : "=v"(r) : "v"(lo), "v"(hi)); return r; }
__device__ __forceinline__ s16x4 vtr(const ATT_LAS unsigned char* p) { typedef short v4i16_t __attribute__((ext_vector_type(4)));
    return __builtin_bit_cast(s16x4, __builtin_amdgcn_ds_read_tr16_b64_v4i16((ATT_LAS v4i16_t*)p)); }

struct Geom { int dil, res, n, qcol, kcol, vcol, ocol, maxs; size_t rowbase; };
__device__ __forceinline__ Geom geom(const Unit& u) {
    Geom g; const int k = u.kind;
    g.dil = (k <= 1) ? 1 : (k == 2 ? 4 : 16);
    const int nper = 32 / g.dil;
    g.res = u.blk / nper; g.n = u.blk % nper;
    g.qcol = (k == 0 ? QA_OFF : QB_OFF) + u.h * HD;
    g.kcol = (k == 0 ? KA_OFF + (u.h >> 3) * HD : KB_OFF + u.h * HD);
    g.vcol = (k == 0 ? VA_OFF + (u.h >> 3) * HD : VB_OFF + u.h * HD);
    g.ocol = k * 1024 + u.h * HD;
    g.maxs = (k == 0) ? 127 : 128;
    g.rowbase = (size_t)u.b * SEQ;
    return g;
}
__device__ __forceinline__ bool next_unit(int i, int vcu, int G, Unit& u) {
    if (G == 256) { if (i >= 32) return false; const int bh = (vcu >> 5) * 8 + (i >> 2); u.b = bh >> 4; u.h = bh & 15; u.kind = i & 3; u.blk = vcu & 31; return true; }
    const int id = i * G + vcu; if (id >= NUNITS) return false;
    u.blk = id & 31; u.kind = (id >> 5) & 3; const int bh = id >> 7; u.b = bh >> 4; u.h = bh & 15; return true;
}
struct Stage { u32x4 k[6], v[6]; };
__device__ __forceinline__ void stage_load(Stage& s, const Tensors& T, const Unit& u, int tid) {
    const Geom g = geom(u);
#pragma unroll
    for (int i = 0; i < 6; ++i) {
        const int cid = tid + 512 * i, j = cid >> 3, c = cid & 7;
        const int lk = 256 * g.n - 128 + j;
        if (lk >= 0) { const size_t row = g.rowbase + (size_t)lk * g.dil + g.res; const bf16_t* p = T.proj + row * DIN + c * 8;
            s.k[i] = *(const u32x4*)(p + g.kcol); s.v[i] = *(const u32x4*)(p + g.vcol); }
        else { s.k[i] = (u32x4){0u, 0u, 0u, 0u}; s.v[i] = (u32x4){0u, 0u, 0u, 0u}; }
    }
}
__device__ __forceinline__ void stage_write(const Stage& s, ATT_LAS unsigned char* lds, int tid) {
#pragma unroll
    for (int i = 0; i < 6; ++i) {
        const int cid = tid + 512 * i, j = cid >> 3, c = cid & 7;
        *(ATT_LAS u32x4*)(lds + LDS_K + c * KCH + j * 16) = s.k[i];
        *(ATT_LAS u32x4*)(lds + LDS_V + (c >> 2) * VH + j * 64 + (c & 3) * 16) = s.v[i];
    }
}
template <bool FIRST_OR_LAST>
__device__ __forceinline__ void tile_step(const ATT_LAS unsigned char* lds, int jt, int t, const bf16x8 (&qf)[4], const float (&cst)[16], float sl2, int maxs,
                                          int qi, int lh, int lane, float& m, float& lpart, f32x16 (&o)[2]) {
    const float tb = -sl2 * (float)(128 - 32 * t);
    f32x16 p;
#pragma unroll
    for (int r = 0; r < 16; ++r) p[r] = cst[r] + tb;
    const ATT_LAS unsigned char* kp = lds + LDS_K + lh * KCH + (jt + qi) * 16;
#pragma unroll
    for (int s = 0; s < 4; ++s) { const bf16x8 kf = *(const ATT_LAS bf16x8*)(kp + 2 * s * KCH); p = __builtin_amdgcn_mfma_f32_32x32x16_bf16(kf, qf[s], p, 0, 0, 0); }
    if (FIRST_OR_LAST) {
        const int sb = 128 - 32 * t + qi;
#pragma unroll
        for (int r = 0; r < 16; ++r) { const int st = sb - crow(r, lh); if (st < 0 || st > maxs) p[r] = -1e30f; }
    }
    float mx = p[0];
#pragma unroll
    for (int r = 1; r < 16; ++r) mx = fmaxf(mx, p[r]);
    { auto rr = __builtin_amdgcn_permlane32_swap(__float_as_uint(mx), __float_as_uint(mx), false, false); mx = fmaxf(__uint_as_float(rr[0]), __uint_as_float(rr[1])); }
    const float mn = fmaxf(m, mx);
    if (__any(mn > m)) { const float al = __builtin_amdgcn_exp2f(m - mn); lpart *= al;
#pragma unroll
        for (int r = 0; r < 16; ++r) { o[0][r] *= al; o[1][r] *= al; }
        m = mn; }
    float rs = 0.f;
#pragma unroll
    for (int r = 0; r < 16; ++r) { p[r] = __builtin_amdgcn_exp2f(p[r] - m); rs += p[r]; }
    lpart += rs;
    bf16x8 pb[2];
#pragma unroll
    for (int s = 0; s < 2; ++s) { u32x4 w; w.x = cvtpk(p[8 * s + 0], p[8 * s + 1]); w.y = cvtpk(p[8 * s + 2], p[8 * s + 3]); w.z = cvtpk(p[8 * s + 4], p[8 * s + 5]); w.w = cvtpk(p[8 * s + 6], p[8 * s + 7]);
        pb[s] = __builtin_bit_cast(bf16x8, w); }
    const ATT_LAS unsigned char* vp = lds + LDS_V + (jt + 4 * lh + ((lane & 15) >> 2)) * 64 + ((lane >> 4) & 1) * 32 + (lane & 3) * 8;
#pragma unroll
    for (int d0 = 0; d0 < 2; ++d0)
#pragma unroll
        for (int s = 0; s < 2; ++s) { const s16x4 lo = vtr(vp + d0 * VH + s * 1024), hi = vtr(vp + d0 * VH + s * 1024 + 512);
            const bf16x8 vf = (bf16x8){lo[0], lo[1], lo[2], lo[3], hi[0], hi[1], hi[2], hi[3]};
            o[d0] = __builtin_amdgcn_mfma_f32_32x32x16_bf16(vf, pb[s], o[d0], 0, 0, 0); }
}
__device__ __forceinline__ void unit_compute(const ATT_LAS unsigned char* lds, const Tensors& T, const Unit& u, int wave, int lane) {
    const Geom g = geom(u);
    const int qi = lane & 31, lh = lane >> 5;
    const int lq = 256 * g.n + 32 * wave + qi;
    const size_t qrow = g.rowbase + (size_t)lq * g.dil + g.res;
    bf16x8 qf[4];
#pragma unroll
    for (int s = 0; s < 4; ++s) qf[s] = *(const bf16x8*)(T.proj + qrow * DIN + g.qcol + 16 * s + 8 * lh);
    const float slope = exp2f(-0.5f * (float)(u.h + 1));
    const float sl2 = slope * LOG2E * (float)g.dil;
    float cst[16];
#pragma unroll
    for (int r = 0; r < 16; ++r) cst[r] = -sl2 * (float)(qi - crow(r, lh));
    float m, lpart;
    if (u.kind == 0) { m = T.sinks[u.h] * LOG2E; lpart = (lh == 0) ? 1.f : 0.f; }
    else { m = -1e30f; lpart = 0.f; }
    f32x16 o[2];
#pragma unroll
    for (int r = 0; r < 16; ++r) { o[0][r] = 0.f; o[1][r] = 0.f; }
    const int kb0 = 256 * g.n - 128 + 32 * wave;
    tile_step<true>(lds, 32 * (wave + 4), 4, qf, cst, sl2, g.maxs, qi, lh, lane, m, lpart, o);
    if (kb0 + 96 >= 0) tile_step<false>(lds, 32 * (wave + 3), 3, qf, cst, sl2, g.maxs, qi, lh, lane, m, lpart, o);
    if (kb0 + 64 >= 0) tile_step<false>(lds, 32 * (wave + 2), 2, qf, cst, sl2, g.maxs, qi, lh, lane, m, lpart, o);
    if (kb0 + 32 >= 0) tile_step<false>(lds, 32 * (wave + 1), 1, qf, cst, sl2, g.maxs, qi, lh, lane, m, lpart, o);
    if (kb0 >= 0)      tile_step<true>(lds, 32 * wave, 0, qf, cst, sl2, g.maxs, qi, lh, lane, m, lpart, o);
    float l;
    { auto rr = __builtin_amdgcn_permlane32_swap(__float_as_uint(lpart), __float_as_uint(lpart), false, false); l = __uint_as_float(rr[0]) + __uint_as_float(rr[1]); }
    const float inv = 1.0f / l;
    if (u.kind != 0 && lh == 0) T.lse[((size_t)(u.kind - 1) * MROWS + qrow) * NH + u.h] = m + log2f(l);
    bf16_t* op = T.oall + qrow * 4096 + g.ocol + 4 * lh;
#pragma unroll
    for (int d0 = 0; d0 < 2; ++d0)
#pragma unroll
        for (int q4 = 0; q4 < 4; ++q4) { u32x2 w; w.x = cvtpk(o[d0][4 * q4 + 0] * inv, o[d0][4 * q4 + 1] * inv); w.y = cvtpk(o[d0][4 * q4 + 2] * inv, o[d0][4 * q4 + 3] * inv);
            *(u32x2*)(op + 32 * d0 + 8 * q4) = w; }
}
__device__ __forceinline__ void phase(ATT_LAS unsigned char* lds, const Tensors& T, int vcu, int G, int tid, int wave, int lane) {
    Unit cur, nxt; Stage st;
    if (!next_unit(0, vcu, G, cur)) return;
    stage_load(st, T, cur, tid);
    for (int i = 0;; ++i) {
        __syncthreads();
        stage_write(st, lds, tid);
        __syncthreads();
        const bool has_next = next_unit(i + 1, vcu, G, nxt);
        if (has_next) stage_load(st, T, nxt, tid);
        unit_compute(lds, T, cur, wave, lane);
        if (!has_next) break;
        cur = nxt;
    }
    __syncthreads();
}
#undef ATT_LAS
}


constexpr int NWAVES = 8;
constexpr int N_LAUNCHES = MK_N_LAUNCHES;
constexpr int N_PHASES = 8;
constexpr size_t MiB = 1u << 20;
constexpr size_t WS_CTL = 0, CTL_ZERO_BYTES = 1 * MiB;
constexpr size_t WS_WIN = 2 * MiB;
constexpr size_t WS_WOUT = 19 * MiB;
constexpr size_t WS_W1 = 27 * MiB;
constexpr size_t WS_W2 = 59 * MiB;
constexpr size_t WS_LSE = 91 * MiB;
constexpr size_t WS_XN = 97 * MiB;
constexpr size_t WS_PROJ = 225 * MiB;
constexpr size_t WS_OALL = 497 * MiB;
constexpr size_t WS_U = 225 * MiB;
constexpr size_t WS_X1B = 753 * MiB;
constexpr size_t WS_END = 881 * MiB;
static_assert(WS_WIN + (size_t)DIN * DM * 2 <= WS_WOUT && WS_WOUT + (size_t)DM * DM * 2 <= WS_W1 && WS_W1 + (size_t)FF * DM * 2 <= WS_W2 && WS_W2 + (size_t)DM * FF * 2 <= WS_LSE, "weights map");
static_assert(WS_LSE + (size_t)3 * MROWS * 16 * 4 <= WS_XN && WS_XN + (size_t)MROWS * DM * 2 <= WS_PROJ && WS_PROJ + (size_t)MROWS * DIN * 2 <= WS_OALL && WS_OALL + (size_t)MROWS * 4096 * 2 <= WS_X1B && WS_X1B + (size_t)MROWS * DM * 2 <= WS_END, "activation map");
static_assert(WS_U >= WS_XN + (size_t)MROWS * DM * 2 && WS_U + (size_t)MROWS * FF * 2 <= WS_X1B, "u overlay");
constexpr int CW_BAR = 4096;
constexpr int CW_SSQ = 65536;
constexpr int RING_OFF = 0, RING_BYTES = 131072;
constexpr int LDSCTL_OFF = RING_BYTES, MISC_OFF = LDSCTL_OFF + 320;
constexpr int LDS_BYTES = 147456;
static_assert((size_t)(CW_SSQ + MROWS) * 4 <= CTL_ZERO_BYTES, "ssq inside the memset region");
static_assert(att::LDS_BYTES <= RING_BYTES && MISC_OFF + 128 <= LDS_BYTES, "LDS map");

#define GAS __attribute__((address_space(1)))
#define LAS __attribute__((address_space(3)))
typedef unsigned short bf16;
typedef unsigned v4u __attribute__((ext_vector_type(4)));
typedef float f32x4 __attribute__((ext_vector_type(4)));
typedef short bf16x8 __attribute__((ext_vector_type(8)));
typedef GAS unsigned gu32;
typedef GAS unsigned long long gu64;
#define RLX_AGENT __ATOMIC_RELAXED, __HIP_MEMORY_SCOPE_AGENT
#define LDS_WAIT() asm volatile("s_waitcnt lgkmcnt(0)" ::: "memory")
#define VM_WAIT() asm volatile("s_waitcnt vmcnt(0)" ::: "memory")
__device__ __forceinline__ unsigned long long rt() { return __builtin_amdgcn_s_memrealtime(); }
__device__ __forceinline__ unsigned f2bf(float f) { unsigned u = __builtin_bit_cast(unsigned, f); return (u + 0x7fffu + ((u >> 16) & 1u)) >> 16; }
__device__ __forceinline__ unsigned pk2(float lo, float hi) { return f2bf(lo) | (f2bf(hi) << 16); }

#define XB_TMO      128
#define XB_XCNT(j)  (256  + 64 * (j))
#define XB_XSUB(j)  (1280 + 64 * (j))
#define XB_XGEN(j)  (2304 + 64 * (j))
#define XB_TOP      3328
#define XB_TOPGEN   3392
#define XCD_BAR_WORDS 3456
#define XB_SPIN_CAP (1u << 18)

__device__ __forceinline__ unsigned xb_ld(unsigned* p)              { return __hip_atomic_load(p, __ATOMIC_RELAXED, __HIP_MEMORY_SCOPE_AGENT); }
__device__ __forceinline__ unsigned xb_add(unsigned* p, unsigned v) { return __hip_atomic_fetch_add(p, v, __ATOMIC_RELAXED, __HIP_MEMORY_SCOPE_AGENT); }
__device__ __forceinline__ unsigned xb_xcc_id() { return (unsigned)__builtin_amdgcn_s_getreg((3 << 11) | 20) & 0xFu; }
#define XB_SPIN(cond, bar) do { unsigned _sp = 0; while (cond) { __builtin_amdgcn_s_sleep(1); \
    if ((++_sp & 255u) == 0u) { if (xb_ld(&(bar)[XB_TMO])) break; if (_sp > XB_SPIN_CAP) { atomicAdd(&(bar)[XB_TMO], 1u); break; } } } } while (0)

struct XcdBarrier {
    unsigned* bar; unsigned x;
    volatile LAS unsigned* st;
};

__device__ __forceinline__ XcdBarrier xcd_barrier_post(unsigned* bar, volatile LAS unsigned* st) {
    XcdBarrier b; b.bar = bar; b.x = xb_xcc_id(); b.st = st;
    if (threadIdx.x == 0) (void)xb_add(&bar[XB_XCNT(b.x)], 1u);
    return b;
}
__device__ __forceinline__ void xcd_barrier_complete(unsigned* bar, unsigned x, unsigned& nloc, unsigned& nx) {
    const unsigned G = gridDim.x * gridDim.y * gridDim.z;
    unsigned sum, cnt, mine, sp = 0u;
    for (;;) {
        sum = 0u; cnt = 0u; mine = 0u;
#pragma unroll
        for (unsigned j = 0; j < 16; ++j) { const unsigned c = xb_ld(&bar[XB_XCNT(j)]); sum += c; cnt += (c > 0u) ? 1u : 0u; mine = (j == x) ? c : mine; }
        if (sum == G) break;
        __builtin_amdgcn_s_sleep(1);
        if ((++sp & 255u) == 0u) { if (xb_ld(&bar[XB_TMO])) break; if (sp > XB_SPIN_CAP) { atomicAdd(&bar[XB_TMO], 1u); break; } }
    }
    nloc = mine > 0u ? mine : 1u; nx = cnt > 0u ? cnt : 1u;
}

__device__ __forceinline__ void xcd_barrier(const XcdBarrier& b) {
    asm volatile("s_waitcnt vmcnt(0)" ::: "memory");
    __syncthreads();
    if (threadIdx.x == 0) {
        unsigned* bar = b.bar;
        __builtin_amdgcn_s_waitcnt(0);
        unsigned nloc = b.st[0], nx = b.st[1];
        if (nloc == 0u) { xcd_barrier_complete(bar, b.x, nloc, nx); b.st[0] = nloc; b.st[1] = nx; }
        const unsigned old = xb_add(&bar[XB_XSUB(b.x)], 1u);
        const unsigned gen = old / nloc;
        if (old + 1u == (gen + 1u) * nloc) {
            __builtin_amdgcn_fence(__ATOMIC_RELEASE, "agent");
            asm volatile("s_waitcnt vmcnt(0)" ::: "memory");
            const unsigned og = xb_add(&bar[XB_TOP], 1u);
            const unsigned tg = og / nx;
            if (og + 1u == (tg + 1u) * nx) xb_add(&bar[XB_TOPGEN], 1u);
            else XB_SPIN(xb_ld(&bar[XB_TOPGEN]) == tg, bar);
            __builtin_amdgcn_fence(__ATOMIC_ACQUIRE, "agent");
            xb_add(&bar[XB_XGEN(b.x)], 1u);
            asm volatile("s_waitcnt vmcnt(0)" ::: "memory");
        } else {
            XB_SPIN(xb_ld(&bar[XB_XGEN(b.x)]) == gen, bar);
            __builtin_amdgcn_fence(__ATOMIC_ACQUIRE, "agent");
            asm volatile("s_waitcnt vmcnt(0)" ::: "memory");
        }
    }
    __syncthreads();
}

__device__ __forceinline__ float wave_sum(float v) {
#pragma unroll
    for (int o = 1; o < 64; o <<= 1) v += __shfl_xor(v, o);
    return v;
}
__device__ __forceinline__ void p0_transpose_item(const float* W, int K, int N, bf16* WT, LAS float* scr, int item, int lane, const float* gain = nullptr) {
    const int nblk = N / 32, kb = item / nblk, nb = item % nblk, k0 = 64 * kb, n0 = 32 * nb;
    float wv[32];
#pragma unroll
    for (int i = 0; i < 32; ++i) { const int kk = 2 * i + (lane >> 5); wv[i] = W[(size_t)(k0 + kk) * N + n0 + (lane & 31)]; }
    if (gain) {
#pragma unroll
        for (int i = 0; i < 32; ++i) wv[i] *= gain[k0 + 2 * i + (lane >> 5)];
    }
#pragma unroll
    for (int i = 0; i < 32; ++i) { const int kk = 2 * i + (lane >> 5); scr[kk * 33 + (lane & 31)] = wv[i]; }
    LDS_WAIT(); asm volatile("" ::: "memory");
    const int c = lane & 7;
#pragma unroll
    for (int j = 0; j < 4; ++j) { const int n = (lane >> 3) + 8 * j; const LAS float* s = scr + (8 * c) * 33 + n;
        v4u o; o.x = pk2(s[0 * 33], s[1 * 33]); o.y = pk2(s[2 * 33], s[3 * 33]); o.z = pk2(s[4 * 33], s[5 * 33]); o.w = pk2(s[6 * 33], s[7 * 33]);
        *(GAS v4u*)(WT + (size_t)(n0 + n) * K + k0 + 8 * c) = o; }
    LDS_WAIT(); asm volatile("" ::: "memory");
}
__device__ __forceinline__ void rms_row_to_bf16(const float* xrow, const float* g, bf16* orow, int lane) {
    const GAS f32x4* xr = (const GAS f32x4*)xrow + lane; const GAS f32x4* gr = (const GAS f32x4*)g + lane;
    f32x4 v[8]; float s = 0.f;
#pragma unroll
    for (int j = 0; j < 8; ++j) { v[j] = xr[64 * j]; s += (v[j].x * v[j].x + v[j].y * v[j].y) + (v[j].z * v[j].z + v[j].w * v[j].w); }
    const float rstd = 1.0f / sqrtf(wave_sum(s) * (1.f / DM) + RMS_EPS);
    GAS unsigned long long* o8 = (GAS unsigned long long*)orow + lane;
#pragma unroll
    for (int j = 0; j < 8; ++j) { const f32x4 gg = gr[64 * j]; const f32x4 y = (v[j] * rstd) * gg;
        o8[64 * j] = (unsigned long long)pk2(y.x, y.y) | ((unsigned long long)pk2(y.z, y.w) << 32); }
}
__device__ __forceinline__ void rms_row_inplace(float* xrow, const float* g, int lane) {
    GAS f32x4* xr = (GAS f32x4*)xrow + lane; const GAS f32x4* gr = (const GAS f32x4*)g + lane;
    f32x4 v[8]; float s = 0.f;
#pragma unroll
    for (int j = 0; j < 8; ++j) { v[j] = xr[64 * j]; s += (v[j].x * v[j].x + v[j].y * v[j].y) + (v[j].z * v[j].z + v[j].w * v[j].w); }
    const float rstd = 1.0f / sqrtf(wave_sum(s) * (1.f / DM) + RMS_EPS);
#pragma unroll
    for (int j = 0; j < 8; ++j) { const f32x4 gg = gr[64 * j]; xr[64 * j] = (v[j] * rstd) * gg; }
}
__device__ __forceinline__ float bf_lo(unsigned w) { return __uint_as_float(w << 16); }
__device__ __forceinline__ float bf_hi(unsigned w) { return __uint_as_float(w & 0xffff0000u); }
__device__ __forceinline__ void combine_row(const bf16* orow  , const float* lse  , const float* ga, const float* gb, bf16* mrow  , int lane) {
    const GAS v4u* o4 = (const GAS v4u*)orow + 2 * lane;
    v4u ra[2], rb[3][2];
#pragma unroll
    for (int q = 0; q < 2; ++q) { ra[q] = o4[q]; rb[0][q] = o4[128 + q]; rb[1][q] = o4[256 + q]; rb[2][q] = o4[384 + q]; }
    const int head = lane >> 2;
    float l0 = lse[head], l1 = lse[(size_t)MROWS * 16 + head], l2 = lse[(size_t)2 * MROWS * 16 + head];
    const float lm = fmaxf(l0, fmaxf(l1, l2));
    float w0 = exp2f(l0 - lm), w1 = exp2f(l1 - lm), w2 = exp2f(l2 - lm);
    const float wi = 1.0f / (w0 + w1 + w2); w0 *= wi; w1 *= wi; w2 *= wi;
    float a[16], b[16]; float sa = 0.f, sb = 0.f;
#pragma unroll
    for (int q = 0; q < 2; ++q)
#pragma unroll
        for (int e = 0; e < 4; ++e) {
            const unsigned wa = ra[q][e], x0 = rb[0][q][e], x1 = rb[1][q][e], x2 = rb[2][q][e];
            const int i = q * 8 + e * 2;
            a[i] = bf_lo(wa); a[i + 1] = bf_hi(wa);
            b[i] = w0 * bf_lo(x0) + w1 * bf_lo(x1) + w2 * bf_lo(x2);
            b[i + 1] = w0 * bf_hi(x0) + w1 * bf_hi(x1) + w2 * bf_hi(x2);
            sa += a[i] * a[i] + a[i + 1] * a[i + 1]; sb += b[i] * b[i] + b[i + 1] * b[i + 1];
        }
    const float ra_ = 1.0f / sqrtf(wave_sum(sa) * (1.f / 1024.f) + RMS_EPS), rb_ = 1.0f / sqrtf(wave_sum(sb) * (1.f / 1024.f) + RMS_EPS);
    const GAS f32x4* ga4 = (const GAS f32x4*)ga + 4 * lane; const GAS f32x4* gb4 = (const GAS f32x4*)gb + 4 * lane;
    GAS v4u* m4 = (GAS v4u*)mrow + 2 * lane;
#pragma unroll
    for (int q = 0; q < 2; ++q) {
        const f32x4 g0 = ga4[2 * q], g1 = ga4[2 * q + 1], h0 = gb4[2 * q], h1 = gb4[2 * q + 1];
        v4u wa, wb; const int i = q * 8;
        wa.x = pk2(a[i + 0] * ra_ * g0.x, a[i + 1] * ra_ * g0.y); wa.y = pk2(a[i + 2] * ra_ * g0.z, a[i + 3] * ra_ * g0.w);
        wa.z = pk2(a[i + 4] * ra_ * g1.x, a[i + 5] * ra_ * g1.y); wa.w = pk2(a[i + 6] * ra_ * g1.z, a[i + 7] * ra_ * g1.w);
        wb.x = pk2(b[i + 0] * rb_ * h0.x, b[i + 1] * rb_ * h0.y); wb.y = pk2(b[i + 2] * rb_ * h0.z, b[i + 3] * rb_ * h0.w);
        wb.z = pk2(b[i + 4] * rb_ * h1.x, b[i + 5] * rb_ * h1.y); wb.w = pk2(b[i + 6] * rb_ * h1.z, b[i + 7] * rb_ * h1.w);
        m4[q] = wa; m4[128 + q] = wb;
    }
}

struct Args { const float* in[12]; float* out; unsigned char* ws; int ph_lo, ph_hi; };
__global__ void __launch_bounds__(NWAVES * 64, 2) block_fwd(Args args) {
    extern __shared__ __attribute__((aligned(16))) unsigned char lds_raw[];
    LAS unsigned char* lds = (LAS unsigned char*)lds_raw;
    volatile LAS unsigned* MISC = (volatile LAS unsigned*)(lds + MISC_OFF);
    const int tid = threadIdx.x, lane = tid & 63, wave = __builtin_amdgcn_readfirstlane(tid >> 6);
    const int G = gridDim.x; const int bx = blockIdx.x;
    const int vcu = (G % 8 == 0) ? (bx % 8) * (G / 8) + bx / 8 : bx;
    unsigned char* ws = args.ws;
    gu32* ctl = (gu32*)(ws + WS_CTL);
    const float* x = args.in[0]; const float* g_attn = args.in[1]; const float* w_in = args.in[2]; const float* b_in = args.in[3]; const float* sinks = args.in[4];
    const float* g_out_a = args.in[5]; const float* g_out_b = args.in[6]; const float* w_out = args.in[7]; const float* g_mlp = args.in[8];
    const float* w_1 = args.in[9]; const float* w_2 = args.in[10]; const float* g_final = args.in[11];
    float* out = args.out;
    bf16* Win_t = (bf16*)(ws + WS_WIN); bf16* Wout_t = (bf16*)(ws + WS_WOUT); bf16* W1_t = (bf16*)(ws + WS_W1); bf16* W2_t = (bf16*)(ws + WS_W2);
    float* LSE = (float*)(ws + WS_LSE); bf16* XN = (bf16*)(ws + WS_XN); bf16* PROJ = (bf16*)(ws + WS_PROJ); bf16* OALL = (bf16*)(ws + WS_OALL); bf16* U = (bf16*)(ws + WS_U); bf16* X1B = (bf16*)(ws + WS_X1B); float* SSQ = (float*)(ctl + CW_SSQ);

    for (int u = tid; u < (LDS_BYTES - LDSCTL_OFF) / 4; u += NWAVES * 64) ((LAS unsigned*)(lds + LDSCTL_OFF))[u] = 0u;
    __syncthreads();
    XcdBarrier bar; bar.bar = (unsigned*)(ctl + CW_BAR); bar.x = 0; bar.st = nullptr;
    if (N_LAUNCHES == 1) bar = xcd_barrier_post((unsigned*)(ctl + CW_BAR), MISC + 8);
    const int lo = args.ph_lo, hi = args.ph_hi;
#define IN(k) (lo <= (k) && (k) < hi)
#define GRID_BAR(k) do { if (IN(k) && IN((k) + 1)) xcd_barrier(bar); } while (0)
    const int gw = vcu * NWAVES + wave, NGW = G * NWAVES;

    constexpr int I_IN = (DM / 64) * (DIN / 32), I_OUT = (DM / 64) * (DM / 32), I_1 = (DM / 64) * (FF / 32), I_2 = (FF / 64) * (DM / 32);
    if (IN(0)) {
        LAS float* scr = (LAS float*)(lds + RING_OFF + wave * 16384);
        for (int it = gw; it < I_IN; it += NGW) p0_transpose_item(w_in, DM, DIN, Win_t, scr, it, lane);
        for (int m = gw; m < MROWS; m += NGW) rms_row_to_bf16(x + (size_t)m * DM, g_attn, XN + (size_t)m * DM, lane);
    }
    GRID_BAR(0);
    if (IN(1)) {
        pg8::Gemm g{XN, Win_t, MROWS, DIN, DM}; pg8::StaticOrder S; S.init(MROWS, DIN, G, bx);
        pg8::EpiProj E{PROJ, DIN, b_in, QSCALE};
        pg8::gemm_phase<pg8::EpiProj, pg8::StaticOrder, true, true>(lds + RING_OFF, g, S, E);
        { pg8::Unit ulast; const int nr = (MROWS / 256) * (DIN / 256) / G;
          const bool shortwg = !S.next(nr, ulast);
          int nshort = G - ((MROWS / 256) * (DIN / 256) - nr * G); if (nshort <= 0 || nshort > G) nshort = G;
          const bool all = (nshort == G);
          if (shortwg || all) {
            LAS float* scr = (LAS float*)(lds + RING_OFF + wave * 16384);
            const int rank = all ? bx : (bx - (G - nshort));
            const int nw2 = nshort * NWAVES;
            for (int it = rank * NWAVES + wave; it < I_OUT + I_1 + I_2; it += nw2) {
                int r = it;
                if (r < I_OUT) { p0_transpose_item(w_out, DM, DM, Wout_t, scr, r, lane); continue; } r -= I_OUT;
                if (r < I_1) { p0_transpose_item(w_1, DM, FF, W1_t, scr, r, lane, g_mlp); continue; } r -= I_1;
                p0_transpose_item(w_2, FF, DM, W2_t, scr, r, lane);
            }
          }
        }
    }
    GRID_BAR(1);
    if (IN(2)) {
        const att::Tensors T{PROJ, OALL, LSE, sinks};
        att::phase(lds + RING_OFF, T, vcu, G, tid, wave, lane);
    }
    GRID_BAR(2);
    if (IN(3)) {
        for (int m = gw; m < MROWS; m += NGW) combine_row(OALL + (size_t)m * 4096, LSE + (size_t)m * 16, g_out_a, g_out_b, XN + (size_t)m * DM, lane);
    }
    GRID_BAR(3);
    if (IN(4)) {
        pg8::Gemm g{XN, Wout_t, MROWS, DM, DM}; pg8::StaticOrder S; S.init(MROWS, DM, G, bx);
        pg8::EpiResF32Bf E{x, out, X1B, SSQ, DM};
        pg8::gemm_phase<pg8::EpiResF32Bf, pg8::StaticOrder, true, true>(lds + RING_OFF, g, S, E);
    }
    GRID_BAR(4);
    if (IN(5)) {
        pg8::Gemm g{X1B, W1_t, MROWS, FF, DM}; pg8::StaticOrder S; S.init(MROWS, FF, G, bx);
        pg8::EpiRelu2S E{U, FF, SSQ, 1.0f / DM, RMS_EPS};
        pg8::gemm_phase<pg8::EpiRelu2S, pg8::StaticOrder, true, true>(lds + RING_OFF, g, S, E);
    }
    GRID_BAR(5);
    if (IN(6)) {
        pg8::Gemm g{U, W2_t, MROWS, DM, FF}; pg8::StaticOrder S; S.init(MROWS, DM, G, bx);
        pg8::EpiResF32 E{out, out, DM};
        pg8::gemm_phase<pg8::EpiResF32, pg8::StaticOrder, true, true>(lds + RING_OFF, g, S, E);
    }
    GRID_BAR(6);
    if (IN(7)) {
        for (int m = gw; m < MROWS; m += NGW) rms_row_inplace(out + (size_t)m * DM, g_final, lane);
    }
#undef IN
#undef GRID_BAR
}

extern "C" void kernel_launch(void* const* d_in, const int* in_sizes, int n_in, void* d_out, int out_size, void* d_ws, size_t ws_size, hipStream_t stream) {
    static int grid = 0;
    if (grid == 0) {
        if (n_in != 12 || in_sizes[0] != MROWS * DM || out_size != MROWS * DM || ws_size < WS_END) {
            fprintf(stderr, "kernel_launch: built for 12 inputs, x/out of %d floats, >= %zu bytes of workspace; got n_in %d, in0 %d, out %d, ws %zu; nothing launched\n", MROWS * DM, (size_t)WS_END, n_in, n_in > 0 ? in_sizes[0] : -1, out_size, ws_size); grid = -1; return; }
        int dev = 0, cus = 0, per_cu = 0;
        if (hipGetDevice(&dev) != hipSuccess || hipDeviceGetAttribute(&cus, hipDeviceAttributeMultiprocessorCount, dev) != hipSuccess) { fprintf(stderr, "kernel_launch: device query failed\n"); grid = -1; return; }
        if (hipFuncSetAttribute((const void*)block_fwd, hipFuncAttributeMaxDynamicSharedMemorySize, LDS_BYTES) != hipSuccess) { fprintf(stderr, "kernel_launch: hipFuncSetAttribute failed\n"); grid = -1; return; }
        if (hipOccupancyMaxActiveBlocksPerMultiprocessor(&per_cu, (const void*)block_fwd, NWAVES * 64, LDS_BYTES) != hipSuccess || per_cu < 1)
            fprintf(stderr, "kernel_launch: note: occupancy query reports %d workgroups per CU\n", per_cu);
        (void)hipGetLastError();
        grid = cus;
    }
    if (grid < 0) return;
    if (hipMemsetAsync((char*)d_ws + WS_CTL, 0, CTL_ZERO_BYTES, stream) != hipSuccess) { fprintf(stderr, "kernel_launch: memset failed\n"); return; }
    Args a{};
    for (int i = 0; i < 12; ++i) a.in[i] = (const float*)d_in[i];
    a.out = (float*)d_out; a.ws = (unsigned char*)d_ws;
    if (N_LAUNCHES == 1) { a.ph_lo = 0; a.ph_hi = N_PHASES; hipLaunchKernelGGL(block_fwd, dim3(grid), dim3(NWAVES * 64), LDS_BYTES, stream, a); }
    else for (int li = 0; li < N_PHASES; ++li) { a.ph_lo = li; a.ph_hi = li + 1; hipLaunchKernelGGL(block_fwd, dim3(grid), dim3(NWAVES * 64), LDS_BYTES, stream, a); }
    const hipError_t le = hipPeekAtLastError();
    if (le != hipSuccess) fprintf(stderr, "kernel_launch: launch failed: %s\n", hipGetErrorName(le));
}
```

```cpp
#include <hip/hip_runtime.h>
#include <hip/hip_bf16.h>
#include <cstdio>
#include <cstdint>

#ifndef MK_N_LAUNCHES
#define MK_N_LAUNCHES 1
#endif

constexpr int BATCH = 4, SEQ = 8192, DM = 2048, DIN = 4352, FF = 8192, NH = 16, HD = 64;
constexpr int MROWS = BATCH * SEQ;
constexpr int QA_OFF = 0, KA_OFF = 1024, VA_OFF = 1152, QB_OFF = 1280, KB_OFF = 2304, VB_OFF = 3328;
constexpr float RMS_EPS = 1e-5f;
constexpr float LOG2E = 1.4426950408889634f;
constexpr float QSCALE = 0.125f * LOG2E;

namespace pg8 {
#define PG8_LAS __attribute__((address_space(3)))
typedef unsigned short bf16_t;
typedef short bf16x8 __attribute__((ext_vector_type(8)));
typedef float f32x4 __attribute__((ext_vector_type(4)));
typedef unsigned u32x4 __attribute__((ext_vector_type(4)));
constexpr int BM = 256, BK = 64, HALF = 128, HTB = HALF * BK * 2  , STAGE_BYTES = 8 * HTB, NXCD = 8, WGM = 8;

__host__ __device__ __forceinline__ int lds_byte(int r, int c) { const int st = (r >> 4) * 2 + (c >> 5), rr = r & 15, cc = c & 31, ob = rr * 64 + cc * 2; return st * 1024 + (ob ^ (((ob >> 9) & 1) << 5)); }
__host__ __device__ __forceinline__ void stage_rc(int b, int& R, int& C) { const int st = b / 1024, sb = b % 1024, swz = sb ^ (((sb >> 9) & 1) << 5); R = (st >> 1) * 16 + swz / 64; C = (st & 1) * 32 + (swz % 64) / 2; }
__host__ __device__ __forceinline__ int perm32(int rho) { const int n = rho >> 4, i = rho & 15; return 8 * (i >> 2) + 4 * n + (i & 3); }

struct Unit { int pm, pn; };
struct Gemm { const bf16_t* A; const bf16_t* Bt; int M, N, K; };

struct StaticOrder {
    int nM, nN, nwg, G, c; int wgm = WGM, rev = 0;
    __host__ __device__ void init(int M, int N, int G_, int c_) { nM = M / BM; nN = N / BM; nwg = nM * nN; G = G_; c = c_; }
    __host__ __device__ bool next(int i, Unit& u) const {
        if (rev) { const int nr = (nwg + G - 1) / G; i = nr - 1 - i; if (i < 0) return false; }
        const long L = (long)i * G + c; if (L >= nwg) return false;
        int wgid = (int)L; { const int q = nwg / NXCD, r = nwg % NXCD, xcd = wgid % NXCD, off = wgid / NXCD; wgid = (xcd < r ? xcd * (q + 1) : r * (q + 1) + (xcd - r) * q) + off; }
        const int nig = wgm * nN, gid = wgid / nig, fm = gid * wgm, gsz = (nM - fm) < wgm ? (nM - fm) : wgm;
        u.pm = fm + ((wgid % nig) % gsz); u.pn = (wgid % nig) / gsz; return true;
    }
    __device__ __forceinline__ void a_ready(const Unit&) const {}
    __device__ __forceinline__ void done(const Unit&) const {}
};

__device__ __forceinline__ unsigned cvt_pk_bf16(float lo, float hi) { unsigned r; asm volatile("v_cvt_pk_bf16_f32 %0, %1, %2" : "=v"(r) : "v"(lo), "v"(hi)); return r; }

struct EpiProj {
    static constexpr bool PERM = true, AFTER_DRAIN = false;
    bf16_t* O; int ldc; const float* bias; float qscale;
    __device__ __forceinline__ void operator()(const f32x4 (&acc)[2][2][4][2], const Unit& u, int wr, int wc, int fr, int fq) const {
        const int row0 = u.pm * BM + wr * 64 + fr;
        const float sc = (u.pn < 4 || (u.pn >= 5 && u.pn < 9)) ? qscale : 1.f;
        const int col0 = u.pn * BM + wc * 32 + 8 * fq;
        f32x4 bv[2][2];
#pragma unroll
        for (int bj = 0; bj < 2; ++bj)
#pragma unroll
            for (int n = 0; n < 2; ++n) bv[bj][n] = *(const f32x4*)(bias + col0 + bj * HALF + 4 * n);
#pragma unroll
        for (int ai = 0; ai < 2; ++ai)
#pragma unroll
            for (int m = 0; m < 4; ++m) { bf16_t* rowp = O + (size_t)(row0 + ai * HALF + m * 16) * ldc + col0;
#pragma unroll
                for (int bj = 0; bj < 2; ++bj) { f32x4 v0 = (acc[ai][bj][m][0] + bv[bj][0]) * sc, v1 = (acc[ai][bj][m][1] + bv[bj][1]) * sc;
                    u32x4 w; w.x = cvt_pk_bf16(v0[0], v0[1]); w.y = cvt_pk_bf16(v0[2], v0[3]); w.z = cvt_pk_bf16(v1[0], v1[1]); w.w = cvt_pk_bf16(v1[2], v1[3]);
                    *(u32x4*)(rowp + bj * HALF) = w; } }
    }
};
struct EpiRelu2 {
    static constexpr bool PERM = true, AFTER_DRAIN = false;
    bf16_t* O; int ldc;
    __device__ __forceinline__ void operator()(const f32x4 (&acc)[2][2][4][2], const Unit& u, int wr, int wc, int fr, int fq) const {
        const int row0 = u.pm * BM + wr * 64 + fr;
        const int col0 = u.pn * BM + wc * 32 + 8 * fq;
#pragma unroll
        for (int ai = 0; ai < 2; ++ai)
#pragma unroll
            for (int m = 0; m < 4; ++m) { bf16_t* rowp = O + (size_t)(row0 + ai * HALF + m * 16) * ldc + col0;
#pragma unroll
                for (int bj = 0; bj < 2; ++bj) { f32x4 v0 = acc[ai][bj][m][0], v1 = acc[ai][bj][m][1];
#pragma unroll
                    for (int e = 0; e < 4; ++e) { const float a = fmaxf(v0[e], 0.f), b = fmaxf(v1[e], 0.f); v0[e] = a * a; v1[e] = b * b; }
                    u32x4 w; w.x = cvt_pk_bf16(v0[0], v0[1]); w.y = cvt_pk_bf16(v0[2], v0[3]); w.z = cvt_pk_bf16(v1[0], v1[1]); w.w = cvt_pk_bf16(v1[2], v1[3]);
                    *(u32x4*)(rowp + bj * HALF) = w; } }
    }
};
struct EpiResF32 {
    static constexpr bool PERM = false, AFTER_DRAIN = false;
    const float* base; float* out; int ldc;
    __device__ __forceinline__ void operator()(const f32x4 (&acc)[2][2][4][2], const Unit& u, int wr, int wc, int fr, int fq) const {
        const int row0 = u.pm * BM + wr * 64 + fr, col0 = u.pn * BM + wc * 32 + 4 * fq;
#pragma unroll
        for (int ai = 0; ai < 2; ++ai)
#pragma unroll
            for (int m = 0; m < 4; ++m) { const size_t off = (size_t)(row0 + ai * HALF + m * 16) * ldc + col0;
                f32x4 bs[2][2];
#pragma unroll
                for (int bj = 0; bj < 2; ++bj)
#pragma unroll
                    for (int n = 0; n < 2; ++n) bs[bj][n] = *(const f32x4*)(base + off + bj * HALF + n * 16);
#pragma unroll
                for (int bj = 0; bj < 2; ++bj)
#pragma unroll
                    for (int n = 0; n < 2; ++n) *(f32x4*)(out + off + bj * HALF + n * 16) = bs[bj][n] + acc[ai][bj][m][n];
                if (m & 1) asm volatile("" ::: "memory"); }
    }
};
struct EpiResF32Bf {
    static constexpr bool PERM = false, AFTER_DRAIN = false;
    const float* base; float* out; bf16_t* xb; float* ssq; int ldc;
    __device__ __forceinline__ void operator()(const f32x4 (&acc)[2][2][4][2], const Unit& u, int wr, int wc, int fr, int fq) const {
        typedef unsigned u32x2 __attribute__((ext_vector_type(2)));
        const int row0 = u.pm * BM + wr * 64 + fr, col0 = u.pn * BM + wc * 32 + 4 * fq;
#pragma unroll
        for (int ai = 0; ai < 2; ++ai)
#pragma unroll
            for (int m = 0; m < 4; ++m) { const int row = row0 + ai * HALF + m * 16; const size_t off = (size_t)row * ldc + col0;
                f32x4 bs[2][2];
#pragma unroll
                for (int bj = 0; bj < 2; ++bj)
#pragma unroll
                    for (int n = 0; n < 2; ++n) bs[bj][n] = *(const f32x4*)(base + off + bj * HALF + n * 16);
                float s = 0.f;
#pragma unroll
                for (int bj = 0; bj < 2; ++bj)
#pragma unroll
                    for (int n = 0; n < 2; ++n) { const f32x4 v = bs[bj][n] + acc[ai][bj][m][n]; *(f32x4*)(out + off + bj * HALF + n * 16) = v;
                        u32x2 w; w.x = cvt_pk_bf16(v[0], v[1]); w.y = cvt_pk_bf16(v[2], v[3]); *(u32x2*)(xb + off + bj * HALF + n * 16) = w;
                        s += (v[0] * v[0] + v[1] * v[1]) + (v[2] * v[2] + v[3] * v[3]); }
                s += __shfl_xor(s, 16); s += __shfl_xor(s, 32);
                if (fq == 0) atomicAdd(ssq + row, s);
                if (m & 1) asm volatile("" ::: "memory"); }
    }
};
struct EpiRelu2S {
    static constexpr bool PERM = true, AFTER_DRAIN = false;
    bf16_t* O; int ldc; const float* ssq; float inv_k, eps;
    __device__ __forceinline__ void operator()(const f32x4 (&acc)[2][2][4][2], const Unit& u, int wr, int wc, int fr, int fq) const {
        const int row0 = u.pm * BM + wr * 64 + fr;
        const int col0 = u.pn * BM + wc * 32 + 8 * fq;
        float rs[2][4];
#pragma unroll
        for (int ai = 0; ai < 2; ++ai)
#pragma unroll
            for (int m = 0; m < 4; ++m) rs[ai][m] = 1.0f / (ssq[row0 + ai * HALF + m * 16] * inv_k + eps);
#pragma unroll
        for (int ai = 0; ai < 2; ++ai)
#pragma unroll
            for (int m = 0; m < 4; ++m) { bf16_t* rowp = O + (size_t)(row0 + ai * HALF + m * 16) * ldc + col0; const float r2 = rs[ai][m];
#pragma unroll
                for (int bj = 0; bj < 2; ++bj) { f32x4 v0 = acc[ai][bj][m][0], v1 = acc[ai][bj][m][1];
#pragma unroll
                    for (int e = 0; e < 4; ++e) { const float a = fmaxf(v0[e], 0.f), b = fmaxf(v1[e], 0.f); v0[e] = a * a * r2; v1[e] = b * b * r2; }
                    u32x4 w; w.x = cvt_pk_bf16(v0[0], v0[1]); w.y = cvt_pk_bf16(v0[2], v0[3]); w.z = cvt_pk_bf16(v1[0], v1[1]); w.w = cvt_pk_bf16(v1[2], v1[3]);
                    *(u32x4*)(rowp + bj * HALF) = w; } }
    }
};

template <class Epi, class Sched, bool ALIGN_EPI = false, bool SP2 = false>
__device__ __forceinline__ void gemm_phase(PG8_LAS unsigned char* lds, const Gemm g, const Sched& S, const Epi& E) {
    const int tid = threadIdx.x, wid = __builtin_amdgcn_readfirstlane(tid >> 6), lane = tid & 63, wr = wid >> 2, wc = wid & 3, fr = lane & 15, fq = lane >> 4;
    const int K = g.K, nt = K / BK;
    unsigned voffA[2], voffB[2];
#pragma unroll
    for (int i = 0; i < 2; ++i) { int R, C; stage_rc(tid * 16 + i * 8192, R, C); const int Rb = Epi::PERM ? ((R & ~31) + perm32(R & 31)) : R;
        voffA[i] = (unsigned)(R * K + C) * 2u; voffB[i] = (unsigned)(Rb * K + C) * 2u; }
    const size_t kstep = (size_t)(BK * 2);
    const size_t hstep = (size_t)HALF * K * 2;
    const size_t tstep = 2 * hstep;
    const unsigned ldsw = (unsigned)wid * 1024u;
    const int aoff = lds_byte(wr * 64 + fr, fq * 8), boff = lds_byte(wc * 32 + fr, fq * 8);
#define PG8_SA(b, h) (((b) * 2 + (h)) * HTB)
#define PG8_SB(b, h) ((4 + (b) * 2 + (h)) * HTB)
#define PG8_STAGE(bufoff, gbase, voff) do { _Pragma("unroll") for (int _i = 0; _i < 2; ++_i) \
        __builtin_amdgcn_global_load_lds((const unsigned*)((const char*)(gbase) + (voff)[_i]), (PG8_LAS unsigned*)(lds + (bufoff) + ldsw + _i * 8192), 16, 0, 0); } while (0)
#define PG8_LDA(dst, b, h) do { _Pragma("unroll") for (int m = 0; m < 4; ++m) _Pragma("unroll") for (int k = 0; k < 2; ++k) dst[m][k] = *(const PG8_LAS bf16x8*)(lds + PG8_SA(b, h) + aoff + m * 2048 + k * 1024); } while (0)
#define PG8_LDB(dst, b, h) do { _Pragma("unroll") for (int n = 0; n < 2; ++n) _Pragma("unroll") for (int k = 0; k < 2; ++k) dst[n][k] = *(const PG8_LAS bf16x8*)(lds + PG8_SB(b, h) + boff + n * 2048 + k * 1024); } while (0)
#define PG8_MMA(ai, bj, At, Bt) do { __builtin_amdgcn_s_setprio(1); _Pragma("unroll") for (int m = 0; m < 4; ++m) _Pragma("unroll") for (int n = 0; n < 2; ++n) _Pragma("unroll") for (int k = 0; k < 2; ++k) \
        acc[ai][bj][m][n] = __builtin_amdgcn_mfma_f32_16x16x32_bf16(Bt[n][k], At[m][k], acc[ai][bj][m][n], 0, 0, 0); __builtin_amdgcn_s_setprio(0); } while (0)
#define PG8_WAIT_V(n) asm volatile("s_waitcnt vmcnt(" #n ")" ::: "memory")
#define PG8_WAIT_L(n) asm volatile("s_waitcnt lgkmcnt(" #n ")" ::: "memory")
#define PG8_BAR __builtin_amdgcn_s_barrier()
#define PG8_SCHED __builtin_amdgcn_sched_barrier(0)
    Unit cur, nxt; int ui = 0;
    if (!S.next(0, cur)) return;
    f32x4 acc[2][2][4][2];
#pragma unroll
    for (int a = 0; a < 2; ++a)
#pragma unroll
        for (int b = 0; b < 2; ++b)
#pragma unroll
            for (int m = 0; m < 4; ++m)
#pragma unroll
                for (int n = 0; n < 2; ++n) acc[a][b][m][n] = (f32x4){0.f, 0.f, 0.f, 0.f};
    bf16x8 At[4][2], B0[2][2], B1[2][2];
    const char* cA = (const char*)g.A + (size_t)cur.pm * tstep; const char* cB = (const char*)g.Bt + (size_t)cur.pn * tstep;
    S.a_ready(cur);
    if constexpr (SP2) {
        PG8_STAGE(PG8_SB(0, 0), cB, voffB); PG8_STAGE(PG8_SB(0, 1), cB + hstep, voffB); PG8_STAGE(PG8_SA(0, 0), cA, voffA); PG8_STAGE(PG8_SA(0, 1), cA + hstep, voffA);
        if (wr == 1) PG8_BAR;
        PG8_WAIT_V(2); PG8_BAR;
        PG8_STAGE(PG8_SB(1, 0), cB + kstep, voffB); PG8_STAGE(PG8_SA(1, 0), cA + kstep, voffA); PG8_STAGE(PG8_SB(1, 1), cB + hstep + kstep, voffB);
        PG8_WAIT_V(6); PG8_BAR;
    } else {
        PG8_STAGE(PG8_SB(0, 0), cB, voffB); PG8_STAGE(PG8_SA(0, 0), cA, voffA); PG8_STAGE(PG8_SB(0, 1), cB + hstep, voffB); PG8_STAGE(PG8_SA(0, 1), cA + hstep, voffA);
        if (wr == 1) PG8_BAR;
        PG8_WAIT_V(4); PG8_BAR;
        PG8_STAGE(PG8_SB(1, 0), cB + kstep, voffB); PG8_STAGE(PG8_SA(1, 0), cA + kstep, voffA); PG8_STAGE(PG8_SB(1, 1), cB + hstep + kstep, voffB);
        PG8_WAIT_V(6); PG8_BAR;
    }
    for (;;) {
        const bool has_next = S.next(ui + 1, nxt);
        const char* nA = has_next ? (const char*)g.A + (size_t)nxt.pm * tstep : cA; const char* nB = has_next ? (const char*)g.Bt + (size_t)nxt.pn * tstep : cB;
        for (int t = 0; t < nt; t += 2) {
            const bool last = (t == nt - 2);
            const char* a1 = cA + (size_t)(t + 1) * kstep;
            const char* a2 = last ? nA : cA + (size_t)(t + 2) * kstep; const char* b2 = last ? nB : cB + (size_t)(t + 2) * kstep;
            const char* a3 = a2 + kstep; const char* b3 = b2 + kstep;
            if (last && has_next) S.a_ready(nxt);
            if constexpr (SP2) {
            PG8_LDB(B0, 0, 0); PG8_LDB(B1, 0, 1); PG8_SCHED; PG8_LDA(At, 0, 0); PG8_STAGE(PG8_SA(1, 1), a1 + hstep, voffA);
            PG8_WAIT_V(8); PG8_WAIT_L(0); PG8_BAR; PG8_MMA(0, 0, At, B0); PG8_MMA(0, 1, At, B1); PG8_BAR; PG8_SCHED;
            PG8_LDA(At, 0, 1); PG8_STAGE(PG8_SB(0, 0), b2, voffB); PG8_STAGE(PG8_SB(0, 1), b2 + hstep, voffB); PG8_STAGE(PG8_SA(0, 0), a2, voffA);
            PG8_WAIT_V(8); PG8_WAIT_L(0); PG8_BAR; PG8_MMA(1, 0, At, B0); PG8_MMA(1, 1, At, B1); PG8_BAR; PG8_SCHED;
            PG8_LDB(B0, 1, 0); PG8_LDB(B1, 1, 1); PG8_SCHED; PG8_LDA(At, 1, 0); PG8_STAGE(PG8_SA(0, 1), a2 + hstep, voffA);
            PG8_WAIT_V(8); PG8_WAIT_L(0); PG8_BAR; PG8_MMA(0, 0, At, B0); PG8_MMA(0, 1, At, B1); PG8_BAR; PG8_SCHED;
            PG8_LDA(At, 1, 1); PG8_STAGE(PG8_SB(1, 0), b3, voffB); PG8_STAGE(PG8_SB(1, 1), b3 + hstep, voffB); PG8_STAGE(PG8_SA(1, 0), a3, voffA);
            PG8_WAIT_V(8); PG8_WAIT_L(0); PG8_BAR; PG8_MMA(1, 0, At, B0); PG8_MMA(1, 1, At, B1); PG8_BAR; PG8_SCHED;
            } else {
            PG8_LDB(B0, 0, 0); PG8_SCHED; PG8_LDA(At, 0, 0); PG8_STAGE(PG8_SA(1, 1), a1 + hstep, voffA);
            PG8_WAIT_L(8); PG8_BAR; PG8_WAIT_L(0); PG8_MMA(0, 0, At, B0); PG8_BAR; PG8_SCHED;
            PG8_LDB(B1, 0, 1); PG8_STAGE(PG8_SB(0, 0), b2, voffB);
            PG8_BAR; PG8_WAIT_L(0); PG8_MMA(0, 1, At, B1); PG8_BAR;
            PG8_LDA(At, 0, 1); PG8_STAGE(PG8_SA(0, 0), a2, voffA);
            PG8_BAR; PG8_WAIT_L(0); PG8_MMA(1, 0, At, B0); PG8_BAR; PG8_SCHED;
            PG8_STAGE(PG8_SB(0, 1), b2 + hstep, voffB);
            PG8_WAIT_V(6); PG8_BAR; PG8_MMA(1, 1, At, B1); PG8_BAR;
            PG8_LDB(B0, 1, 0); PG8_SCHED; PG8_LDA(At, 1, 0); PG8_STAGE(PG8_SA(0, 1), a2 + hstep, voffA);
            PG8_WAIT_L(8); PG8_BAR; PG8_WAIT_L(0); PG8_MMA(0, 0, At, B0); PG8_BAR; PG8_SCHED;
            PG8_LDB(B1, 1, 1); PG8_STAGE(PG8_SB(1, 0), b3, voffB);
            PG8_BAR; PG8_WAIT_L(0); PG8_MMA(0, 1, At, B1); PG8_BAR;
            PG8_LDA(At, 1, 1); PG8_STAGE(PG8_SA(1, 0), a3, voffA);
            PG8_BAR; PG8_WAIT_L(0); PG8_MMA(1, 0, At, B0); PG8_BAR; PG8_SCHED;
            PG8_STAGE(PG8_SB(1, 1), b3 + hstep, voffB);
            PG8_WAIT_V(6); PG8_BAR; PG8_MMA(1, 1, At, B1); PG8_BAR;
            }
        }
        if constexpr (ALIGN_EPI) { if (wr == 0) PG8_BAR; }
        if constexpr (!Epi::AFTER_DRAIN) { E(acc, cur, wr, wc, fr, fq); S.done(cur); }
        if (!has_next) break;
#pragma unroll
        for (int a = 0; a < 2; ++a)
#pragma unroll
            for (int b = 0; b < 2; ++b)
#pragma unroll
                for (int m = 0; m < 4; ++m)
#pragma unroll
                    for (int n = 0; n < 2; ++n) acc[a][b][m][n] = (f32x4){0.f, 0.f, 0.f, 0.f};
        cur = nxt; cA = nA; cB = nB; ++ui;
        if constexpr (ALIGN_EPI) { if (wr == 1) PG8_BAR; }
    }
    PG8_WAIT_V(0);
    if constexpr (!ALIGN_EPI) { if (wr == 0) PG8_BAR; }
    PG8_BAR;
    if constexpr (Epi::AFTER_DRAIN) { E.fused(acc, cur, wr, wc, fr, fq, lds, wid, lane); S.done(cur); }
#undef PG8_SA
#undef PG8_SB
#undef PG8_STAGE
#undef PG8_LDA
#undef PG8_LDB
#undef PG8_MMA
#undef PG8_WAIT_V
#undef PG8_WAIT_L
#undef PG8_BAR
#undef PG8_SCHED
}
}
namespace att {
#define ATT_LAS __attribute__((address_space(3)))
typedef short bf16x8 __attribute__((ext_vector_type(8)));
typedef short s16x4 __attribute__((ext_vector_type(4)));
typedef float f32x16 __attribute__((ext_vector_type(16)));
typedef unsigned u32x4 __attribute__((ext_vector_type(4)));
typedef unsigned u32x2 __attribute__((ext_vector_type(2)));
typedef unsigned short bf16_t;
constexpr int NKEY = 384;
constexpr int KCH = NKEY * 16 + 16;
constexpr int VH = NKEY * 64 + 64;
constexpr int LDS_K = 0, LDS_V = 8 * KCH, LDS_BYTES = LDS_V + 2 * VH;
struct Tensors { const bf16_t* proj; bf16_t* oall; float* lse; const float* sinks; };
struct Unit { int kind, b, h, blk; };
__device__ __forceinline__ int crow(int r, int lh) { return (r & 3) + 8 * (r >> 2) + 4 * lh; }
__device__ __forceinline__ unsigned cvtpk(float lo, float hi) { unsigned r; asm("v_cvt_pk_bf16_f32 %0, %1, %2" : "=v"(r) : "v"(lo), "v"(hi)); return r; }
__device__ __forceinline__ s16x4 vtr(const ATT_LAS unsigned char* p) { typedef short v4i16_t __attribute__((ext_vector_type(4)));
    return __builtin_bit_cast(s16x4, __builtin_amdgcn_ds_read_tr16_b64_v4i16((ATT_LAS v4i16_t*)p)); }

struct Geom { int dil, res, n, qcol, kcol, vcol, ocol, maxs; size_t rowbase; };
__device__ __forceinline__ Geom geom(const Unit& u) {
    Geom g; const int k = u.kind;
    g.dil = (k <= 1) ? 1 : (k == 2 ? 4 : 16);
    const int nper = 32 / g.dil;
    g.res = u.blk / nper; g.n = u.blk % nper;
    g.qcol = (k == 0 ? QA_OFF : QB_OFF) + u.h * HD;
    g.kcol = (k == 0 ? KA_OFF + (u.h >> 3) * HD : KB_OFF + u.h * HD);
    g.vcol = (k == 0 ? VA_OFF + (u.h >> 3) * HD : VB_OFF + u.h * HD);
    g.ocol = k * 1024 + u.h * HD;
    g.maxs = (k == 0) ? 127 : 128;
    g.rowbase = (size_t)u.b * SEQ;
    return g;
}
constexpr int NUNITS_A = BATCH * 2 * 32, NUNITS_B = BATCH * NH * 3 * 32;
__device__ __forceinline__ bool next_unit(int i, int vcu, int G, Unit& u) {
    int kind, bh, h8, blk; bool ok;
    if (G == 256) {
        ok = i < 25; const int j = i - 1;
        kind = (i == 0) ? 0 : 1 + j % 3; blk = vcu & 31;
        bh = (i == 0) ? (vcu >> 6) * 16 : (vcu >> 5) * 8 + j / 3;
        h8 = ((vcu >> 5) & 1) * 8;
    } else {
        const int id = i * G + vcu; ok = id < NUNITS_A + NUNITS_B; const int j = id - NUNITS_A;
        kind = (id < NUNITS_A) ? 0 : 1 + (j >> 5) % 3; blk = (id < NUNITS_A) ? (id & 31) : (j & 31);
        bh = (id < NUNITS_A) ? (id >> 6) * 16 : j / 96;
        h8 = ((id >> 5) & 1) * 8;
    }
    u.kind = kind; u.b = bh >> 4; u.h = (kind == 0) ? h8 : (bh & 15); u.blk = blk;
    return ok;
}
struct Stage { u32x4 k[6], v[6]; bf16x8 q[4]; };
__device__ __forceinline__ void q_load(bf16x8 (&q)[4], const Tensors& T, const Geom& g, int qcol, int tid) {
    const int wave = tid >> 6, lane = tid & 63, qi = lane & 31, lh = lane >> 5;
    const size_t qrow = g.rowbase + (size_t)(256 * g.n + 32 * wave + qi) * g.dil + g.res;
#pragma unroll
    for (int s = 0; s < 4; ++s) q[s] = *(const bf16x8*)(T.proj + qrow * DIN + qcol + 16 * s + 8 * lh);
}
__device__ __forceinline__ void stage_load(Stage& s, const Tensors& T, const Unit& u, int tid) {
    const Geom g = geom(u);
    q_load(s.q, T, g, g.qcol, tid);
#pragma unroll
    for (int i = 0; i < 6; ++i) {
        const int cid = tid + 512 * i, j = cid >> 3, c = cid & 7;
        const int lk = 256 * g.n - 128 + j;
        if (lk >= 0) { const size_t row = g.rowbase + (size_t)lk * g.dil + g.res; const bf16_t* p = T.proj + row * DIN + c * 8;
            s.k[i] = *(const u32x4*)(p + g.kcol); s.v[i] = *(const u32x4*)(p + g.vcol); }
        else { s.k[i] = (u32x4){0u, 0u, 0u, 0u}; s.v[i] = (u32x4){0u, 0u, 0u, 0u}; }
    }
}
__device__ __forceinline__ void stage_write(const Stage& s, ATT_LAS unsigned char* lds, int tid) {
#pragma unroll
    for (int i = 0; i < 6; ++i) {
        const int cid = tid + 512 * i, j = cid >> 3, c = cid & 7;
        *(ATT_LAS u32x4*)(lds + LDS_K + c * KCH + j * 16) = s.k[i];
        *(ATT_LAS u32x4*)(lds + LDS_V + (c >> 2) * VH + j * 64 + (c & 3) * 16) = s.v[i];
    }
}
template <bool FIRST_OR_LAST>
__device__ __forceinline__ void tile_step(const ATT_LAS unsigned char* lds, int jt, int t, const bf16x8 (&qf)[4], float sl2, int maxs,
                                          int qi, int lh, int lane, float& m, float& lpart, f32x16 (&o)[2]) {
    const float tb = -sl2 * (float)(128 - 32 * t + qi - 4 * lh);
    f32x16 p;
#pragma unroll
    for (int r = 0; r < 16; ++r) p[r] = fmaf(sl2, (float)((r & 3) + 8 * (r >> 2)), tb);
    const ATT_LAS unsigned char* kp = lds + LDS_K + lh * KCH + (jt + qi) * 16;
#pragma unroll
    for (int s = 0; s < 4; ++s) { const bf16x8 kf = *(const ATT_LAS bf16x8*)(kp + 2 * s * KCH); p = __builtin_amdgcn_mfma_f32_32x32x16_bf16(kf, qf[s], p, 0, 0, 0); }
    if (FIRST_OR_LAST) {
        const int sb = 128 - 32 * t + qi;
#pragma unroll
        for (int r = 0; r < 16; ++r) { const int st = sb - crow(r, lh); if (st < 0 || st > maxs) p[r] = -1e30f; }
    }
    float mx = p[0];
#pragma unroll
    for (int r = 1; r < 16; ++r) mx = fmaxf(mx, p[r]);
    { auto rr = __builtin_amdgcn_permlane32_swap(__float_as_uint(mx), __float_as_uint(mx), false, false); mx = fmaxf(__uint_as_float(rr[0]), __uint_as_float(rr[1])); }
    const float mn = fmaxf(m, mx);
    if (__any(mn > m)) { const float al = __builtin_amdgcn_exp2f(m - mn); lpart *= al;
#pragma unroll
        for (int r = 0; r < 16; ++r) { o[0][r] *= al; o[1][r] *= al; }
        m = mn; }
    float rs = 0.f;
#pragma unroll
    for (int r = 0; r < 16; ++r) { p[r] = __builtin_amdgcn_exp2f(p[r] - m); rs += p[r]; }
    lpart += rs;
    bf16x8 pb[2];
#pragma unroll
    for (int s = 0; s < 2; ++s) { u32x4 w; w.x = cvtpk(p[8 * s + 0], p[8 * s + 1]); w.y = cvtpk(p[8 * s + 2], p[8 * s + 3]); w.z = cvtpk(p[8 * s + 4], p[8 * s + 5]); w.w = cvtpk(p[8 * s + 6], p[8 * s + 7]);
        pb[s] = __builtin_bit_cast(bf16x8, w); }
    const ATT_LAS unsigned char* vp = lds + LDS_V + (jt + 4 * lh + ((lane & 15) >> 2)) * 64 + ((lane >> 4) & 1) * 32 + (lane & 3) * 8;
#pragma unroll
    for (int d0 = 0; d0 < 2; ++d0)
#pragma unroll
        for (int s = 0; s < 2; ++s) { const s16x4 lo = vtr(vp + d0 * VH + s * 1024), hi = vtr(vp + d0 * VH + s * 1024 + 512);
            const bf16x8 vf = (bf16x8){lo[0], lo[1], lo[2], lo[3], hi[0], hi[1], hi[2], hi[3]};
            o[d0] = __builtin_amdgcn_mfma_f32_32x32x16_bf16(vf, pb[s], o[d0], 0, 0, 0); }
}
__device__ __forceinline__ void head_compute(const ATT_LAS unsigned char* lds, const Tensors& T, const Unit& u, const Geom& g, int h, int hh, const bf16x8 (&qf)[4], int wave, int lane) {
    const int qi = lane & 31, lh = lane >> 5;
    const int lq = 256 * g.n + 32 * wave + qi;
    const size_t qrow = g.rowbase + (size_t)lq * g.dil + g.res;
    const int kb0 = 256 * g.n - 128 + 32 * wave;
    const float slope = exp2f(-0.5f * (float)(h + 1));
    const float sl2 = slope * LOG2E * (float)g.dil;
    float m, lpart;
    if (u.kind == 0) { m = T.sinks[h] * LOG2E; lpart = (lh == 0) ? 1.f : 0.f; }
    else { m = -1e30f; lpart = 0.f; }
    f32x16 o[2];
#pragma unroll
    for (int r = 0; r < 16; ++r) { o[0][r] = 0.f; o[1][r] = 0.f; }
    tile_step<true>(lds, 32 * (wave + 4), 4, qf, sl2, g.maxs, qi, lh, lane, m, lpart, o);
    if (kb0 + 96 >= 0) tile_step<false>(lds, 32 * (wave + 3), 3, qf, sl2, g.maxs, qi, lh, lane, m, lpart, o);
    if (kb0 + 64 >= 0) tile_step<false>(lds, 32 * (wave + 2), 2, qf, sl2, g.maxs, qi, lh, lane, m, lpart, o);
    if (kb0 + 32 >= 0) tile_step<false>(lds, 32 * (wave + 1), 1, qf, sl2, g.maxs, qi, lh, lane, m, lpart, o);
    if (kb0 >= 0)      tile_step<true>(lds, 32 * wave, 0, qf, sl2, g.maxs, qi, lh, lane, m, lpart, o);
    float l;
    { auto rr = __builtin_amdgcn_permlane32_swap(__float_as_uint(lpart), __float_as_uint(lpart), false, false); l = __uint_as_float(rr[0]) + __uint_as_float(rr[1]); }
    const float inv = 1.0f / l;
    if (u.kind != 0 && lh == 0) T.lse[((size_t)(u.kind - 1) * MROWS + qrow) * NH + h] = m + log2f(l);
    bf16_t* op = T.oall + qrow * 4096 + g.ocol + hh * HD + 4 * lh;
#pragma unroll
    for (int d0 = 0; d0 < 2; ++d0)
#pragma unroll
        for (int q4 = 0; q4 < 4; ++q4) { u32x2 w; w.x = cvtpk(o[d0][4 * q4 + 0] * inv, o[d0][4 * q4 + 1] * inv); w.y = cvtpk(o[d0][4 * q4 + 2] * inv, o[d0][4 * q4 + 3] * inv);
            *(u32x2*)(op + 32 * d0 + 8 * q4) = w; }
}
__device__ __forceinline__ void phase(ATT_LAS unsigned char* lds, const Tensors& T, int vcu, int G, int tid, int wave, int lane) {
    Unit cur, nxt; Stage st;
    if (!next_unit(0, vcu, G, cur)) return;
    stage_load(st, T, cur, tid);
    for (int i = 0;; ++i) {
        __syncthreads();
        stage_write(st, lds, tid);
        bf16x8 qf[4] = {st.q[0], st.q[1], st.q[2], st.q[3]};
        __syncthreads();
        const bool has_next = next_unit(i + 1, vcu, G, nxt);
        const Geom g = geom(cur);
        if (cur.kind != 0) {
            if (has_next) stage_load(st, T, nxt, tid);
            head_compute(lds, T, cur, g, cur.h, 0, qf, wave, lane);
        } else {
            for (int hh = 0; hh < 8; ++hh) {
                if (hh < 7) q_load(st.q, T, g, g.qcol + (hh + 1) * HD, tid);
                head_compute(lds, T, cur, g, cur.h + hh, hh, qf, wave, lane);
#pragma unroll
                for (int s = 0; s < 4; ++s) qf[s] = st.q[s];
            }
            if (has_next) stage_load(st, T, nxt, tid);
        }
        if (!has_next) break;
        cur = nxt;
    }
    __syncthreads();
}
#undef ATT_LAS
}


constexpr int NWAVES = 8;
constexpr int N_LAUNCHES = MK_N_LAUNCHES;
constexpr int N_PHASES = 8;
constexpr size_t MiB = 1u << 20;
constexpr size_t WS_CTL = 0, CTL_ZERO_BYTES = 1 * MiB;
constexpr size_t WS_WIN = 2 * MiB;
constexpr size_t WS_WOUT = 19 * MiB;
constexpr size_t WS_W1 = 27 * MiB;
constexpr size_t WS_W2 = 59 * MiB;
constexpr size_t WS_LSE = 91 * MiB;
constexpr size_t WS_XN = 97 * MiB;
constexpr size_t WS_PROJ = 225 * MiB;
constexpr size_t WS_OALL = 497 * MiB;
constexpr size_t WS_U = 225 * MiB;
constexpr size_t WS_X1B = 753 * MiB;
constexpr size_t WS_END = 881 * MiB;
static_assert(WS_WIN + (size_t)DIN * DM * 2 <= WS_WOUT && WS_WOUT + (size_t)DM * DM * 2 <= WS_W1 && WS_W1 + (size_t)FF * DM * 2 <= WS_W2 && WS_W2 + (size_t)DM * FF * 2 <= WS_LSE, "weights map");
static_assert(WS_LSE + (size_t)3 * MROWS * 16 * 4 <= WS_XN && WS_XN + (size_t)MROWS * DM * 2 <= WS_PROJ && WS_PROJ + (size_t)MROWS * DIN * 2 <= WS_OALL && WS_OALL + (size_t)MROWS * 4096 * 2 <= WS_X1B && WS_X1B + (size_t)MROWS * DM * 2 <= WS_END, "activation map");
static_assert(WS_U >= WS_XN + (size_t)MROWS * DM * 2 && WS_U + (size_t)MROWS * FF * 2 <= WS_X1B, "u overlay");
constexpr int CW_BAR = 4096;
constexpr int CW_SSQ = 65536;
constexpr int RING_OFF = 0, RING_BYTES = 131072;
constexpr int LDSCTL_OFF = RING_BYTES, MISC_OFF = LDSCTL_OFF + 320;
constexpr int LDS_BYTES = 147456;
static_assert((size_t)(CW_SSQ + MROWS) * 4 <= CTL_ZERO_BYTES, "ssq inside the memset region");
static_assert(att::LDS_BYTES <= RING_BYTES && MISC_OFF + 128 <= LDS_BYTES, "LDS map");

#define GAS __attribute__((address_space(1)))
#define LAS __attribute__((address_space(3)))
typedef unsigned short bf16;
typedef unsigned v4u __attribute__((ext_vector_type(4)));
typedef float f32x4 __attribute__((ext_vector_type(4)));
typedef short bf16x8 __attribute__((ext_vector_type(8)));
typedef GAS unsigned gu32;
typedef GAS unsigned long long gu64;
#define RLX_AGENT __ATOMIC_RELAXED, __HIP_MEMORY_SCOPE_AGENT
#define LDS_WAIT() asm volatile("s_waitcnt lgkmcnt(0)" ::: "memory")
#define VM_WAIT() asm volatile("s_waitcnt vmcnt(0)" ::: "memory")
__device__ __forceinline__ unsigned long long rt() { return __builtin_amdgcn_s_memrealtime(); }
__device__ __forceinline__ unsigned f2bf(float f) { unsigned u = __builtin_bit_cast(unsigned, f); return (u + 0x7fffu + ((u >> 16) & 1u)) >> 16; }
__device__ __forceinline__ unsigned pk2(float lo, float hi) { return f2bf(lo) | (f2bf(hi) << 16); }

#define XB_TMO      128
#define XB_XCNT(j)  (256  + 64 * (j))
#define XB_XSUB(j)  (1280 + 64 * (j))
#define XB_XGEN(j)  (2304 + 64 * (j))
#define XB_TOP      3328
#define XB_TOPGEN   3392
#define XCD_BAR_WORDS 3456
#define XB_SPIN_CAP (1u << 18)

__device__ __forceinline__ unsigned xb_ld(unsigned* p)              { return __hip_atomic_load(p, __ATOMIC_RELAXED, __HIP_MEMORY_SCOPE_AGENT); }
__device__ __forceinline__ unsigned xb_add(unsigned* p, unsigned v) { return __hip_atomic_fetch_add(p, v, __ATOMIC_RELAXED, __HIP_MEMORY_SCOPE_AGENT); }
__device__ __forceinline__ unsigned xb_xcc_id() { return (unsigned)__builtin_amdgcn_s_getreg((3 << 11) | 20) & 0xFu; }
#define XB_SPIN(cond, bar) do { unsigned _sp = 0; while (cond) { __builtin_amdgcn_s_sleep(1); \
    if ((++_sp & 255u) == 0u) { if (xb_ld(&(bar)[XB_TMO])) break; if (_sp > XB_SPIN_CAP) { atomicAdd(&(bar)[XB_TMO], 1u); break; } } } } while (0)

struct XcdBarrier {
    unsigned* bar; unsigned x;
    volatile LAS unsigned* st;
};

__device__ __forceinline__ XcdBarrier xcd_barrier_post(unsigned* bar, volatile LAS unsigned* st) {
    XcdBarrier b; b.bar = bar; b.x = xb_xcc_id(); b.st = st;
    if (threadIdx.x == 0) (void)xb_add(&bar[XB_XCNT(b.x)], 1u);
    return b;
}
__device__ __forceinline__ void xcd_barrier_complete(unsigned* bar, unsigned x, unsigned& nloc, unsigned& nx) {
    const unsigned G = gridDim.x * gridDim.y * gridDim.z;
    unsigned sum, cnt, mine, sp = 0u;
    for (;;) {
        sum = 0u; cnt = 0u; mine = 0u;
#pragma unroll
        for (unsigned j = 0; j < 16; ++j) { const unsigned c = xb_ld(&bar[XB_XCNT(j)]); sum += c; cnt += (c > 0u) ? 1u : 0u; mine = (j == x) ? c : mine; }
        if (sum == G) break;
        __builtin_amdgcn_s_sleep(1);
        if ((++sp & 255u) == 0u) { if (xb_ld(&bar[XB_TMO])) break; if (sp > XB_SPIN_CAP) { atomicAdd(&bar[XB_TMO], 1u); break; } }
    }
    nloc = mine > 0u ? mine : 1u; nx = cnt > 0u ? cnt : 1u;
}

__device__ __forceinline__ void xcd_barrier(const XcdBarrier& b) {
    asm volatile("s_waitcnt vmcnt(0)" ::: "memory");
    __syncthreads();
    if (threadIdx.x == 0) {
        unsigned* bar = b.bar;
        __builtin_amdgcn_s_waitcnt(0);
        unsigned nloc = b.st[0], nx = b.st[1];
        if (nloc == 0u) { xcd_barrier_complete(bar, b.x, nloc, nx); b.st[0] = nloc; b.st[1] = nx; }
        const unsigned old = xb_add(&bar[XB_XSUB(b.x)], 1u);
        const unsigned gen = old / nloc;
        if (old + 1u == (gen + 1u) * nloc) {
            __builtin_amdgcn_fence(__ATOMIC_RELEASE, "agent");
            asm volatile("s_waitcnt vmcnt(0)" ::: "memory");
            const unsigned og = xb_add(&bar[XB_TOP], 1u);
            const unsigned tg = og / nx;
            if (og + 1u == (tg + 1u) * nx) xb_add(&bar[XB_TOPGEN], 1u);
            else XB_SPIN(xb_ld(&bar[XB_TOPGEN]) == tg, bar);
            __builtin_amdgcn_fence(__ATOMIC_ACQUIRE, "agent");
            xb_add(&bar[XB_XGEN(b.x)], 1u);
            asm volatile("s_waitcnt vmcnt(0)" ::: "memory");
        } else {
            XB_SPIN(xb_ld(&bar[XB_XGEN(b.x)]) == gen, bar);
            __builtin_amdgcn_fence(__ATOMIC_ACQUIRE, "agent");
            asm volatile("s_waitcnt vmcnt(0)" ::: "memory");
        }
    }
    __syncthreads();
}

__device__ __forceinline__ float wave_sum(float v) {
#pragma unroll
    for (int o = 1; o < 64; o <<= 1) v += __shfl_xor(v, o);
    return v;
}
__device__ __forceinline__ void p0_transpose_item(const float* W, int K, int N, bf16* WT, LAS float* scr, int item, int lane, const float* gain = nullptr) {
    const int nblk = N / 32, kb = item / nblk, nb = item % nblk, k0 = 64 * kb, n0 = 32 * nb;
    float wv[32];
#pragma unroll
    for (int i = 0; i < 32; ++i) { const int kk = 2 * i + (lane >> 5); wv[i] = W[(size_t)(k0 + kk) * N + n0 + (lane & 31)]; }
    if (gain) {
#pragma unroll
        for (int i = 0; i < 32; ++i) wv[i] *= gain[k0 + 2 * i + (lane >> 5)];
    }
#pragma unroll
    for (int i = 0; i < 32; ++i) { const int kk = 2 * i + (lane >> 5); scr[kk * 33 + (lane & 31)] = wv[i]; }
    LDS_WAIT(); asm volatile("" ::: "memory");
    const int c = lane & 7;
#pragma unroll
    for (int j = 0; j < 4; ++j) { const int n = (lane >> 3) + 8 * j; const LAS float* s = scr + (8 * c) * 33 + n;
        v4u o; o.x = pk2(s[0 * 33], s[1 * 33]); o.y = pk2(s[2 * 33], s[3 * 33]); o.z = pk2(s[4 * 33], s[5 * 33]); o.w = pk2(s[6 * 33], s[7 * 33]);
        *(GAS v4u*)(WT + (size_t)(n0 + n) * K + k0 + 8 * c) = o; }
    LDS_WAIT(); asm volatile("" ::: "memory");
}
__device__ __forceinline__ void rms_row_to_bf16(const float* xrow, const float* g, bf16* orow, int lane) {
    const GAS f32x4* xr = (const GAS f32x4*)xrow + lane; const GAS f32x4* gr = (const GAS f32x4*)g + lane;
    f32x4 v[8]; float s = 0.f;
#pragma unroll
    for (int j = 0; j < 8; ++j) { v[j] = xr[64 * j]; s += (v[j].x * v[j].x + v[j].y * v[j].y) + (v[j].z * v[j].z + v[j].w * v[j].w); }
    const float rstd = 1.0f / sqrtf(wave_sum(s) * (1.f / DM) + RMS_EPS);
    GAS unsigned long long* o8 = (GAS unsigned long long*)orow + lane;
#pragma unroll
    for (int j = 0; j < 8; ++j) { const f32x4 gg = gr[64 * j]; const f32x4 y = (v[j] * rstd) * gg;
        o8[64 * j] = (unsigned long long)pk2(y.x, y.y) | ((unsigned long long)pk2(y.z, y.w) << 32); }
}
__device__ __forceinline__ void rms_row_inplace(float* xrow, const float* g, int lane) {
    GAS f32x4* xr = (GAS f32x4*)xrow + lane; const GAS f32x4* gr = (const GAS f32x4*)g + lane;
    f32x4 v[8]; float s = 0.f;
#pragma unroll
    for (int j = 0; j < 8; ++j) { v[j] = xr[64 * j]; s += (v[j].x * v[j].x + v[j].y * v[j].y) + (v[j].z * v[j].z + v[j].w * v[j].w); }
    const float rstd = 1.0f / sqrtf(wave_sum(s) * (1.f / DM) + RMS_EPS);
#pragma unroll
    for (int j = 0; j < 8; ++j) { const f32x4 gg = gr[64 * j]; xr[64 * j] = (v[j] * rstd) * gg; }
}
__device__ __forceinline__ float bf_lo(unsigned w) { return __uint_as_float(w << 16); }
__device__ __forceinline__ float bf_hi(unsigned w) { return __uint_as_float(w & 0xffff0000u); }
__device__ __forceinline__ void combine_row(const bf16* orow  , const float* lse  , const float* ga, const float* gb, bf16* mrow  , int lane) {
    const GAS v4u* o4 = (const GAS v4u*)orow + 2 * lane;
    v4u ra[2], rb[3][2];
#pragma unroll
    for (int q = 0; q < 2; ++q) { ra[q] = o4[q]; rb[0][q] = o4[128 + q]; rb[1][q] = o4[256 + q]; rb[2][q] = o4[384 + q]; }
    const int head = lane >> 2;
    float l0 = lse[head], l1 = lse[(size_t)MROWS * 16 + head], l2 = lse[(size_t)2 * MROWS * 16 + head];
    const float lm = fmaxf(l0, fmaxf(l1, l2));
    float w0 = exp2f(l0 - lm), w1 = exp2f(l1 - lm), w2 = exp2f(l2 - lm);
    const float wi = 1.0f / (w0 + w1 + w2); w0 *= wi; w1 *= wi; w2 *= wi;
    float a[16], b[16]; float sa = 0.f, sb = 0.f;
#pragma unroll
    for (int q = 0; q < 2; ++q)
#pragma unroll
        for (int e = 0; e < 4; ++e) {
            const unsigned wa = ra[q][e], x0 = rb[0][q][e], x1 = rb[1][q][e], x2 = rb[2][q][e];
            const int i = q * 8 + e * 2;
            a[i] = bf_lo(wa); a[i + 1] = bf_hi(wa);
            b[i] = w0 * bf_lo(x0) + w1 * bf_lo(x1) + w2 * bf_lo(x2);
            b[i + 1] = w0 * bf_hi(x0) + w1 * bf_hi(x1) + w2 * bf_hi(x2);
            sa += a[i] * a[i] + a[i + 1] * a[i + 1]; sb += b[i] * b[i] + b[i + 1] * b[i + 1];
        }
    const float ra_ = 1.0f / sqrtf(wave_sum(sa) * (1.f / 1024.f) + RMS_EPS), rb_ = 1.0f / sqrtf(wave_sum(sb) * (1.f / 1024.f) + RMS_EPS);
    const GAS f32x4* ga4 = (const GAS f32x4*)ga + 4 * lane; const GAS f32x4* gb4 = (const GAS f32x4*)gb + 4 * lane;
    GAS v4u* m4 = (GAS v4u*)mrow + 2 * lane;
#pragma unroll
    for (int q = 0; q < 2; ++q) {
        const f32x4 g0 = ga4[2 * q], g1 = ga4[2 * q + 1], h0 = gb4[2 * q], h1 = gb4[2 * q + 1];
        v4u wa, wb; const int i = q * 8;
        wa.x = pk2(a[i + 0] * ra_ * g0.x, a[i + 1] * ra_ * g0.y); wa.y = pk2(a[i + 2] * ra_ * g0.z, a[i + 3] * ra_ * g0.w);
        wa.z = pk2(a[i + 4] * ra_ * g1.x, a[i + 5] * ra_ * g1.y); wa.w = pk2(a[i + 6] * ra_ * g1.z, a[i + 7] * ra_ * g1.w);
        wb.x = pk2(b[i + 0] * rb_ * h0.x, b[i + 1] * rb_ * h0.y); wb.y = pk2(b[i + 2] * rb_ * h0.z, b[i + 3] * rb_ * h0.w);
        wb.z = pk2(b[i + 4] * rb_ * h1.x, b[i + 5] * rb_ * h1.y); wb.w = pk2(b[i + 6] * rb_ * h1.z, b[i + 7] * rb_ * h1.w);
        m4[q] = wa; m4[128 + q] = wb;
    }
}

struct Args { const float* in[12]; float* out; unsigned char* ws; int ph_lo, ph_hi; };
__global__ void __launch_bounds__(NWAVES * 64, 2) block_fwd(Args args) {
    extern __shared__ __attribute__((aligned(16))) unsigned char lds_raw[];
    LAS unsigned char* lds = (LAS unsigned char*)lds_raw;
    volatile LAS unsigned* MISC = (volatile LAS unsigned*)(lds + MISC_OFF);
    const int tid = threadIdx.x, lane = tid & 63, wave = __builtin_amdgcn_readfirstlane(tid >> 6);
    const int G = gridDim.x; const int bx = blockIdx.x;
    const int vcu = (G % 8 == 0) ? (bx % 8) * (G / 8) + bx / 8 : bx;
    unsigned char* ws = args.ws;
    gu32* ctl = (gu32*)(ws + WS_CTL);
    const float* x = args.in[0]; const float* g_attn = args.in[1]; const float* w_in = args.in[2]; const float* b_in = args.in[3]; const float* sinks = args.in[4];
    const float* g_out_a = args.in[5]; const float* g_out_b = args.in[6]; const float* w_out = args.in[7]; const float* g_mlp = args.in[8];
    const float* w_1 = args.in[9]; const float* w_2 = args.in[10]; const float* g_final = args.in[11];
    float* out = args.out;
    bf16* Win_t = (bf16*)(ws + WS_WIN); bf16* Wout_t = (bf16*)(ws + WS_WOUT); bf16* W1_t = (bf16*)(ws + WS_W1); bf16* W2_t = (bf16*)(ws + WS_W2);
    float* LSE = (float*)(ws + WS_LSE); bf16* XN = (bf16*)(ws + WS_XN); bf16* PROJ = (bf16*)(ws + WS_PROJ); bf16* OALL = (bf16*)(ws + WS_OALL); bf16* U = (bf16*)(ws + WS_U); bf16* X1B = (bf16*)(ws + WS_X1B); float* SSQ = (float*)(ctl + CW_SSQ);

    for (int u = tid; u < (LDS_BYTES - LDSCTL_OFF) / 4; u += NWAVES * 64) ((LAS unsigned*)(lds + LDSCTL_OFF))[u] = 0u;
    __syncthreads();
    XcdBarrier bar; bar.bar = (unsigned*)(ctl + CW_BAR); bar.x = 0; bar.st = nullptr;
    if (N_LAUNCHES == 1) bar = xcd_barrier_post((unsigned*)(ctl + CW_BAR), MISC + 8);
    const int lo = args.ph_lo, hi = args.ph_hi;
#define IN(k) (lo <= (k) && (k) < hi)
#define GRID_BAR(k) do { if (IN(k) && IN((k) + 1)) xcd_barrier(bar); } while (0)
    const int gw = vcu * NWAVES + wave, NGW = G * NWAVES;

    constexpr int I_IN = (DM / 64) * (DIN / 32), I_OUT = (DM / 64) * (DM / 32), I_1 = (DM / 64) * (FF / 32), I_2 = (FF / 64) * (DM / 32);
    if (IN(0)) {
        LAS float* scr = (LAS float*)(lds + RING_OFF + wave * 16384);
        for (int it = gw; it < I_IN; it += NGW) p0_transpose_item(w_in, DM, DIN, Win_t, scr, it, lane);
        for (int m = gw; m < MROWS; m += NGW) rms_row_to_bf16(x + (size_t)m * DM, g_attn, XN + (size_t)m * DM, lane);
    }
    GRID_BAR(0);
    if (IN(1)) {
        pg8::Gemm g{XN, Win_t, MROWS, DIN, DM}; pg8::StaticOrder S; S.init(MROWS, DIN, G, bx);
        pg8::EpiProj E{PROJ, DIN, b_in, QSCALE};
        pg8::gemm_phase<pg8::EpiProj, pg8::StaticOrder, true, true>(lds + RING_OFF, g, S, E);
        { pg8::Unit ulast; const int nr = (MROWS / 256) * (DIN / 256) / G;
          const bool shortwg = !S.next(nr, ulast);
          int nshort = G - ((MROWS / 256) * (DIN / 256) - nr * G); if (nshort <= 0 || nshort > G) nshort = G;
          const bool all = (nshort == G);
          if (shortwg || all) {
            LAS float* scr = (LAS float*)(lds + RING_OFF + wave * 16384);
            const int rank = all ? bx : (bx - (G - nshort));
            const int nw2 = nshort * NWAVES;
            for (int it = rank * NWAVES + wave; it < I_OUT + I_1 + I_2; it += nw2) {
                int r = it;
                if (r < I_OUT) { p0_transpose_item(w_out, DM, DM, Wout_t, scr, r, lane); continue; } r -= I_OUT;
                if (r < I_1) { p0_transpose_item(w_1, DM, FF, W1_t, scr, r, lane, g_mlp); continue; } r -= I_1;
                p0_transpose_item(w_2, FF, DM, W2_t, scr, r, lane);
            }
          }
        }
    }
    GRID_BAR(1);
    if (IN(2)) {
        const att::Tensors T{PROJ, OALL, LSE, sinks};
        att::phase(lds + RING_OFF, T, vcu, G, tid, wave, lane);
    }
    GRID_BAR(2);
    if (IN(3)) {
        for (int m = gw; m < MROWS; m += NGW) combine_row(OALL + (size_t)m * 4096, LSE + (size_t)m * 16, g_out_a, g_out_b, XN + (size_t)m * DM, lane);
    }
    GRID_BAR(3);
    if (IN(4)) {
        pg8::Gemm g{XN, Wout_t, MROWS, DM, DM}; pg8::StaticOrder S; S.init(MROWS, DM, G, bx);
        pg8::EpiResF32Bf E{x, out, X1B, SSQ, DM};
        pg8::gemm_phase<pg8::EpiResF32Bf, pg8::StaticOrder, true, true>(lds + RING_OFF, g, S, E);
    }
    GRID_BAR(4);
    if (IN(5)) {
        pg8::Gemm g{X1B, W1_t, MROWS, FF, DM}; pg8::StaticOrder S; S.init(MROWS, FF, G, bx);
        pg8::EpiRelu2S E{U, FF, SSQ, 1.0f / DM, RMS_EPS};
        pg8::gemm_phase<pg8::EpiRelu2S, pg8::StaticOrder, true, true>(lds + RING_OFF, g, S, E);
    }
    GRID_BAR(5);
    if (IN(6)) {
        pg8::Gemm g{U, W2_t, MROWS, DM, FF}; pg8::StaticOrder S; S.init(MROWS, DM, G, bx); S.wgm = 4; S.rev = 1;
        pg8::EpiResF32 E{out, out, DM};
        pg8::gemm_phase<pg8::EpiResF32, pg8::StaticOrder, true, true>(lds + RING_OFF, g, S, E);
    }
    GRID_BAR(6);
    if (IN(7)) {
        for (int m = gw; m < MROWS; m += NGW) rms_row_inplace(out + (size_t)m * DM, g_final, lane);
    }
#undef IN
#undef GRID_BAR
}

extern "C" void kernel_launch(void* const* d_in, const int* in_sizes, int n_in, void* d_out, int out_size, void* d_ws, size_t ws_size, hipStream_t stream) {
    static int grid = 0;
    if (grid == 0) {
        if (n_in != 12 || in_sizes[0] != MROWS * DM || out_size != MROWS * DM || ws_size < WS_END) {
            fprintf(stderr, "kernel_launch: built for 12 inputs, x/out of %d floats, >= %zu bytes of workspace; got n_in %d, in0 %d, out %d, ws %zu; nothing launched\n", MROWS * DM, (size_t)WS_END, n_in, n_in > 0 ? in_sizes[0] : -1, out_size, ws_size); grid = -1; return; }
        int dev = 0, cus = 0, per_cu = 0;
        if (hipGetDevice(&dev) != hipSuccess || hipDeviceGetAttribute(&cus, hipDeviceAttributeMultiprocessorCount, dev) != hipSuccess) { fprintf(stderr, "kernel_launch: device query failed\n"); grid = -1; return; }
        if (hipFuncSetAttribute((const void*)block_fwd, hipFuncAttributeMaxDynamicSharedMemorySize, LDS_BYTES) != hipSuccess) { fprintf(stderr, "kernel_launch: hipFuncSetAttribute failed\n"); grid = -1; return; }
        if (hipOccupancyMaxActiveBlocksPerMultiprocessor(&per_cu, (const void*)block_fwd, NWAVES * 64, LDS_BYTES) != hipSuccess || per_cu < 1)
            fprintf(stderr, "kernel_launch: note: occupancy query reports %d workgroups per CU\n", per_cu);
        (void)hipGetLastError();
        grid = cus;
    }
    if (grid < 0) return;
    if (hipMemsetAsync((char*)d_ws + WS_CTL, 0, CTL_ZERO_BYTES, stream) != hipSuccess) { fprintf(stderr, "kernel_launch: memset failed\n"); return; }
    Args a{};
    for (int i = 0; i < 12; ++i) a.in[i] = (const float*)d_in[i];
    a.out = (float*)d_out; a.ws = (unsigned char*)d_ws;
    if (N_LAUNCHES == 1) { a.ph_lo = 0; a.ph_hi = N_PHASES; hipLaunchKernelGGL(block_fwd, dim3(grid), dim3(NWAVES * 64), LDS_BYTES, stream, a); }
    else for (int li = 0; li < N_PHASES; ++li) { a.ph_lo = li; a.ph_hi = li + 1; hipLaunchKernelGGL(block_fwd, dim3(grid), dim3(NWAVES * 64), LDS_BYTES, stream, a); }
    const hipError_t le = hipPeekAtLastError();
    if (le != hipSuccess) fprintf(stderr, "kernel_launch: launch failed: %s\n", hipGetErrorName(le));
}
```

```cpp
#include <hip/hip_runtime.h>
#include <hip/hip_bf16.h>
#include <cstdio>
#include <cstdint>

#ifndef MK_N_LAUNCHES
#define MK_N_LAUNCHES 1
#endif

constexpr int BATCH = 4, SEQ = 8192, DM = 2048, DIN = 4352, FF = 8192, NH = 16, HD = 64;
constexpr int MROWS = BATCH * SEQ;
constexpr int QA_OFF = 0, KA_OFF = 1024, VA_OFF = 1152, QB_OFF = 1280, KB_OFF = 2304, VB_OFF = 3328;
constexpr float RMS_EPS = 1e-5f;
constexpr float LOG2E = 1.4426950408889634f;
constexpr float QSCALE = 0.125f * LOG2E;

namespace pg8 {
#define PG8_LAS __attribute__((address_space(3)))
typedef unsigned short bf16_t;
typedef short bf16x8 __attribute__((ext_vector_type(8)));
typedef float f32x4 __attribute__((ext_vector_type(4)));
typedef unsigned u32x4 __attribute__((ext_vector_type(4)));
constexpr int BM = 256, BK = 64, HALF = 128, HTB = HALF * BK * 2  , STAGE_BYTES = 8 * HTB, NXCD = 8, WGM = 8;

__host__ __device__ __forceinline__ int lds_byte(int r, int c) { const int st = (r >> 4) * 2 + (c >> 5), rr = r & 15, cc = c & 31, ob = rr * 64 + cc * 2; return st * 1024 + (ob ^ (((ob >> 9) & 1) << 5)); }
__host__ __device__ __forceinline__ void stage_rc(int b, int& R, int& C) { const int st = b / 1024, sb = b % 1024, swz = sb ^ (((sb >> 9) & 1) << 5); R = (st >> 1) * 16 + swz / 64; C = (st & 1) * 32 + (swz % 64) / 2; }
__host__ __device__ __forceinline__ int perm32(int rho) { const int n = rho >> 4, i = rho & 15; return 8 * (i >> 2) + 4 * n + (i & 3); }

struct Unit { int pm, pn; };
struct Gemm { const bf16_t* A; const bf16_t* Bt; int M, N, K; };

struct StaticOrder {
    int nM, nN, nwg, G, c; int wgm = WGM, rev = 0;
    __host__ __device__ void init(int M, int N, int G_, int c_) { nM = M / BM; nN = N / BM; nwg = nM * nN; G = G_; c = c_; }
    __host__ __device__ bool next(int i, Unit& u) const {
        if (rev) { const int nr = (nwg + G - 1) / G; i = nr - 1 - i; if (i < 0) return false; }
        const long L = (long)i * G + c; if (L >= nwg) return false;
        int wgid = (int)L; { const int q = nwg / NXCD, r = nwg % NXCD, xcd = wgid % NXCD, off = wgid / NXCD; wgid = (xcd < r ? xcd * (q + 1) : r * (q + 1) + (xcd - r) * q) + off; }
        const int nig = wgm * nN, gid = wgid / nig, fm = gid * wgm, gsz = (nM - fm) < wgm ? (nM - fm) : wgm;
        u.pm = fm + ((wgid % nig) % gsz); u.pn = (wgid % nig) / gsz; return true;
    }
    __device__ __forceinline__ void a_ready(const Unit&) const {}
    __device__ __forceinline__ void done(const Unit&) const {}
};

__device__ __forceinline__ unsigned cvt_pk_bf16(float lo, float hi) { unsigned r; asm volatile("v_cvt_pk_bf16_f32 %0, %1, %2" : "=v"(r) : "v"(lo), "v"(hi)); return r; }

struct EpiProj {
    static constexpr bool PERM = true, AFTER_DRAIN = false;
    bf16_t* O; int ldc; const float* bias; float qscale;
    __device__ __forceinline__ void operator()(const f32x4 (&acc)[2][2][4][2], const Unit& u, int wr, int wc, int fr, int fq) const {
        const int row0 = u.pm * BM + wr * 64 + fr;
        const float sc = (u.pn < 4 || (u.pn >= 5 && u.pn < 9)) ? qscale : 1.f;
        const int col0 = u.pn * BM + wc * 32 + 8 * fq;
        f32x4 bv[2][2];
#pragma unroll
        for (int bj = 0; bj < 2; ++bj)
#pragma unroll
            for (int n = 0; n < 2; ++n) bv[bj][n] = *(const f32x4*)(bias + col0 + bj * HALF + 4 * n);
#pragma unroll
        for (int ai = 0; ai < 2; ++ai)
#pragma unroll
            for (int m = 0; m < 4; ++m) { bf16_t* rowp = O + (size_t)(row0 + ai * HALF + m * 16) * ldc + col0;
#pragma unroll
                for (int bj = 0; bj < 2; ++bj) { f32x4 v0 = (acc[ai][bj][m][0] + bv[bj][0]) * sc, v1 = (acc[ai][bj][m][1] + bv[bj][1]) * sc;
                    u32x4 w; w.x = cvt_pk_bf16(v0[0], v0[1]); w.y = cvt_pk_bf16(v0[2], v0[3]); w.z = cvt_pk_bf16(v1[0], v1[1]); w.w = cvt_pk_bf16(v1[2], v1[3]);
                    *(u32x4*)(rowp + bj * HALF) = w; } }
    }
};
struct EpiRelu2 {
    static constexpr bool PERM = true, AFTER_DRAIN = false;
    bf16_t* O; int ldc;
    __device__ __forceinline__ void operator()(const f32x4 (&acc)[2][2][4][2], const Unit& u, int wr, int wc, int fr, int fq) const {
        const int row0 = u.pm * BM + wr * 64 + fr;
        const int col0 = u.pn * BM + wc * 32 + 8 * fq;
#pragma unroll
        for (int ai = 0; ai < 2; ++ai)
#pragma unroll
            for (int m = 0; m < 4; ++m) { bf16_t* rowp = O + (size_t)(row0 + ai * HALF + m * 16) * ldc + col0;
#pragma unroll
                for (int bj = 0; bj < 2; ++bj) { f32x4 v0 = acc[ai][bj][m][0], v1 = acc[ai][bj][m][1];
#pragma unroll
                    for (int e = 0; e < 4; ++e) { const float a = fmaxf(v0[e], 0.f), b = fmaxf(v1[e], 0.f); v0[e] = a * a; v1[e] = b * b; }
                    u32x4 w; w.x = cvt_pk_bf16(v0[0], v0[1]); w.y = cvt_pk_bf16(v0[2], v0[3]); w.z = cvt_pk_bf16(v1[0], v1[1]); w.w = cvt_pk_bf16(v1[2], v1[3]);
                    *(u32x4*)(rowp + bj * HALF) = w; } }
    }
};
struct EpiResF32 {
    static constexpr bool PERM = false, AFTER_DRAIN = false;
    const float* base; float* out; int ldc;
    __device__ __forceinline__ void operator()(const f32x4 (&acc)[2][2][4][2], const Unit& u, int wr, int wc, int fr, int fq) const {
        const int row0 = u.pm * BM + wr * 64 + fr, col0 = u.pn * BM + wc * 32 + 4 * fq;
#pragma unroll
        for (int ai = 0; ai < 2; ++ai)
#pragma unroll
            for (int m = 0; m < 4; ++m) { const size_t off = (size_t)(row0 + ai * HALF + m * 16) * ldc + col0;
                f32x4 bs[2][2];
#pragma unroll
                for (int bj = 0; bj < 2; ++bj)
#pragma unroll
                    for (int n = 0; n < 2; ++n) bs[bj][n] = *(const f32x4*)(base + off + bj * HALF + n * 16);
#pragma unroll
                for (int bj = 0; bj < 2; ++bj)
#pragma unroll
                    for (int n = 0; n < 2; ++n) *(f32x4*)(out + off + bj * HALF + n * 16) = bs[bj][n] + acc[ai][bj][m][n];
                if (m & 1) asm volatile("" ::: "memory"); }
    }
};
struct EpiResF32Bf {
    static constexpr bool PERM = false, AFTER_DRAIN = false;
    const float* base; float* out; bf16_t* xb; float* ssq; int ldc;
    __device__ __forceinline__ void operator()(const f32x4 (&acc)[2][2][4][2], const Unit& u, int wr, int wc, int fr, int fq) const {
        typedef unsigned u32x2 __attribute__((ext_vector_type(2)));
        const int row0 = u.pm * BM + wr * 64 + fr, col0 = u.pn * BM + wc * 32 + 4 * fq;
#pragma unroll
        for (int ai = 0; ai < 2; ++ai)
#pragma unroll
            for (int m = 0; m < 4; ++m) { const int row = row0 + ai * HALF + m * 16; const size_t off = (size_t)row * ldc + col0;
                f32x4 bs[2][2];
#pragma unroll
                for (int bj = 0; bj < 2; ++bj)
#pragma unroll
                    for (int n = 0; n < 2; ++n) bs[bj][n] = *(const f32x4*)(base + off + bj * HALF + n * 16);
                float s = 0.f;
#pragma unroll
                for (int bj = 0; bj < 2; ++bj)
#pragma unroll
                    for (int n = 0; n < 2; ++n) { const f32x4 v = bs[bj][n] + acc[ai][bj][m][n]; *(f32x4*)(out + off + bj * HALF + n * 16) = v;
                        u32x2 w; w.x = cvt_pk_bf16(v[0], v[1]); w.y = cvt_pk_bf16(v[2], v[3]); *(u32x2*)(xb + off + bj * HALF + n * 16) = w;
                        s += (v[0] * v[0] + v[1] * v[1]) + (v[2] * v[2] + v[3] * v[3]); }
                s += __shfl_xor(s, 16); s += __shfl_xor(s, 32);
                if (fq == 0) atomicAdd(ssq + row, s);
                if (m & 1) asm volatile("" ::: "memory"); }
    }
};
struct EpiRelu2S {
    static constexpr bool PERM = true, AFTER_DRAIN = false;
    bf16_t* O; int ldc; const float* ssq; float inv_k, eps;
    __device__ __forceinline__ void operator()(const f32x4 (&acc)[2][2][4][2], const Unit& u, int wr, int wc, int fr, int fq) const {
        const int row0 = u.pm * BM + wr * 64 + fr;
        const int col0 = u.pn * BM + wc * 32 + 8 * fq;
        float rs[2][4];
#pragma unroll
        for (int ai = 0; ai < 2; ++ai)
#pragma unroll
            for (int m = 0; m < 4; ++m) rs[ai][m] = 1.0f / (ssq[row0 + ai * HALF + m * 16] * inv_k + eps);
#pragma unroll
        for (int ai = 0; ai < 2; ++ai)
#pragma unroll
            for (int m = 0; m < 4; ++m) { bf16_t* rowp = O + (size_t)(row0 + ai * HALF + m * 16) * ldc + col0; const float r2 = rs[ai][m];
#pragma unroll
                for (int bj = 0; bj < 2; ++bj) { f32x4 v0 = acc[ai][bj][m][0], v1 = acc[ai][bj][m][1];
#pragma unroll
                    for (int e = 0; e < 4; ++e) { const float a = fmaxf(v0[e], 0.f), b = fmaxf(v1[e], 0.f); v0[e] = a * a * r2; v1[e] = b * b * r2; }
                    u32x4 w; w.x = cvt_pk_bf16(v0[0], v0[1]); w.y = cvt_pk_bf16(v0[2], v0[3]); w.z = cvt_pk_bf16(v1[0], v1[1]); w.w = cvt_pk_bf16(v1[2], v1[3]);
                    *(u32x4*)(rowp + bj * HALF) = w; } }
    }
};

template <class Epi, class Sched, bool ALIGN_EPI = false, bool SP2 = false>
__device__ __forceinline__ void gemm_phase(PG8_LAS unsigned char* lds, const Gemm g, const Sched& S, const Epi& E) {
    const int tid = threadIdx.x, wid = __builtin_amdgcn_readfirstlane(tid >> 6), lane = tid & 63, wr = wid >> 2, wc = wid & 3, fr = lane & 15, fq = lane >> 4;
    const int K = g.K, nt = K / BK;
    unsigned voffA[2], voffB[2];
#pragma unroll
    for (int i = 0; i < 2; ++i) { int R, C; stage_rc(tid * 16 + i * 8192, R, C); const int Rb = Epi::PERM ? ((R & ~31) + perm32(R & 31)) : R;
        voffA[i] = (unsigned)(R * K + C) * 2u; voffB[i] = (unsigned)(Rb * K + C) * 2u; }
    const size_t kstep = (size_t)(BK * 2);
    const size_t hstep = (size_t)HALF * K * 2;
    const size_t tstep = 2 * hstep;
    const unsigned ldsw = (unsigned)wid * 1024u;
    const int aoff = lds_byte(wr * 64 + fr, fq * 8), boff = lds_byte(wc * 32 + fr, fq * 8);
#define PG8_SA(b, h) (((b) * 2 + (h)) * HTB)
#define PG8_SB(b, h) ((4 + (b) * 2 + (h)) * HTB)
#define PG8_STAGE(bufoff, gbase, voff) do { _Pragma("unroll") for (int _i = 0; _i < 2; ++_i) \
        __builtin_amdgcn_global_load_lds((const unsigned*)((const char*)(gbase) + (voff)[_i]), (PG8_LAS unsigned*)(lds + (bufoff) + ldsw + _i * 8192), 16, 0, 0); } while (0)
#define PG8_LDA(dst, b, h) do { _Pragma("unroll") for (int m = 0; m < 4; ++m) _Pragma("unroll") for (int k = 0; k < 2; ++k) dst[m][k] = *(const PG8_LAS bf16x8*)(lds + PG8_SA(b, h) + aoff + m * 2048 + k * 1024); } while (0)
#define PG8_LDB(dst, b, h) do { _Pragma("unroll") for (int n = 0; n < 2; ++n) _Pragma("unroll") for (int k = 0; k < 2; ++k) dst[n][k] = *(const PG8_LAS bf16x8*)(lds + PG8_SB(b, h) + boff + n * 2048 + k * 1024); } while (0)
#define PG8_MMA(ai, bj, At, Bt) do { __builtin_amdgcn_s_setprio(1); _Pragma("unroll") for (int m = 0; m < 4; ++m) _Pragma("unroll") for (int n = 0; n < 2; ++n) _Pragma("unroll") for (int k = 0; k < 2; ++k) \
        acc[ai][bj][m][n] = __builtin_amdgcn_mfma_f32_16x16x32_bf16(Bt[n][k], At[m][k], acc[ai][bj][m][n], 0, 0, 0); __builtin_amdgcn_s_setprio(0); } while (0)
#define PG8_WAIT_V(n) asm volatile("s_waitcnt vmcnt(" #n ")" ::: "memory")
#define PG8_WAIT_L(n) asm volatile("s_waitcnt lgkmcnt(" #n ")" ::: "memory")
#define PG8_BAR __builtin_amdgcn_s_barrier()
#define PG8_SCHED __builtin_amdgcn_sched_barrier(0)
    Unit cur, nxt; int ui = 0;
    if (!S.next(0, cur)) return;
    f32x4 acc[2][2][4][2];
#pragma unroll
    for (int a = 0; a < 2; ++a)
#pragma unroll
        for (int b = 0; b < 2; ++b)
#pragma unroll
            for (int m = 0; m < 4; ++m)
#pragma unroll
                for (int n = 0; n < 2; ++n) acc[a][b][m][n] = (f32x4){0.f, 0.f, 0.f, 0.f};
    bf16x8 At[4][2], B0[2][2], B1[2][2];
    const char* cA = (const char*)g.A + (size_t)cur.pm * tstep; const char* cB = (const char*)g.Bt + (size_t)cur.pn * tstep;
    S.a_ready(cur);
    if constexpr (SP2) {
        PG8_STAGE(PG8_SB(0, 0), cB, voffB); PG8_STAGE(PG8_SB(0, 1), cB + hstep, voffB); PG8_STAGE(PG8_SA(0, 0), cA, voffA); PG8_STAGE(PG8_SA(0, 1), cA + hstep, voffA);
        if (wr == 1) PG8_BAR;
        PG8_WAIT_V(2); PG8_BAR;
        PG8_STAGE(PG8_SB(1, 0), cB + kstep, voffB); PG8_STAGE(PG8_SA(1, 0), cA + kstep, voffA); PG8_STAGE(PG8_SB(1, 1), cB + hstep + kstep, voffB);
        PG8_WAIT_V(6); PG8_BAR;
    } else {
        PG8_STAGE(PG8_SB(0, 0), cB, voffB); PG8_STAGE(PG8_SA(0, 0), cA, voffA); PG8_STAGE(PG8_SB(0, 1), cB + hstep, voffB); PG8_STAGE(PG8_SA(0, 1), cA + hstep, voffA);
        if (wr == 1) PG8_BAR;
        PG8_WAIT_V(4); PG8_BAR;
        PG8_STAGE(PG8_SB(1, 0), cB + kstep, voffB); PG8_STAGE(PG8_SA(1, 0), cA + kstep, voffA); PG8_STAGE(PG8_SB(1, 1), cB + hstep + kstep, voffB);
        PG8_WAIT_V(6); PG8_BAR;
    }
    for (;;) {
        const bool has_next = S.next(ui + 1, nxt);
        const char* nA = has_next ? (const char*)g.A + (size_t)nxt.pm * tstep : cA; const char* nB = has_next ? (const char*)g.Bt + (size_t)nxt.pn * tstep : cB;
        for (int t = 0; t < nt; t += 2) {
            const bool last = (t == nt - 2);
            const char* a1 = cA + (size_t)(t + 1) * kstep;
            const char* a2 = last ? nA : cA + (size_t)(t + 2) * kstep; const char* b2 = last ? nB : cB + (size_t)(t + 2) * kstep;
            const char* a3 = a2 + kstep; const char* b3 = b2 + kstep;
            if (last && has_next) S.a_ready(nxt);
            if constexpr (SP2) {
            PG8_LDB(B0, 0, 0); PG8_LDB(B1, 0, 1); PG8_SCHED; PG8_LDA(At, 0, 0); PG8_STAGE(PG8_SA(1, 1), a1 + hstep, voffA);
            PG8_WAIT_V(8); PG8_WAIT_L(0); PG8_BAR; PG8_MMA(0, 0, At, B0); PG8_MMA(0, 1, At, B1); PG8_BAR; PG8_SCHED;
            PG8_LDA(At, 0, 1); PG8_STAGE(PG8_SB(0, 0), b2, voffB); PG8_STAGE(PG8_SB(0, 1), b2 + hstep, voffB); PG8_STAGE(PG8_SA(0, 0), a2, voffA);
            PG8_WAIT_V(8); PG8_WAIT_L(0); PG8_BAR; PG8_MMA(1, 0, At, B0); PG8_MMA(1, 1, At, B1); PG8_BAR; PG8_SCHED;
            PG8_LDB(B0, 1, 0); PG8_LDB(B1, 1, 1); PG8_SCHED; PG8_LDA(At, 1, 0); PG8_STAGE(PG8_SA(0, 1), a2 + hstep, voffA);
            PG8_WAIT_V(8); PG8_WAIT_L(0); PG8_BAR; PG8_MMA(0, 0, At, B0); PG8_MMA(0, 1, At, B1); PG8_BAR; PG8_SCHED;
            PG8_LDA(At, 1, 1); PG8_STAGE(PG8_SB(1, 0), b3, voffB); PG8_STAGE(PG8_SB(1, 1), b3 + hstep, voffB); PG8_STAGE(PG8_SA(1, 0), a3, voffA);
            PG8_WAIT_V(8); PG8_WAIT_L(0); PG8_BAR; PG8_MMA(1, 0, At, B0); PG8_MMA(1, 1, At, B1); PG8_BAR; PG8_SCHED;
            } else {
            PG8_LDB(B0, 0, 0); PG8_SCHED; PG8_LDA(At, 0, 0); PG8_STAGE(PG8_SA(1, 1), a1 + hstep, voffA);
            PG8_WAIT_L(8); PG8_BAR; PG8_WAIT_L(0); PG8_MMA(0, 0, At, B0); PG8_BAR; PG8_SCHED;
            PG8_LDB(B1, 0, 1); PG8_STAGE(PG8_SB(0, 0), b2, voffB);
            PG8_BAR; PG8_WAIT_L(0); PG8_MMA(0, 1, At, B1); PG8_BAR;
            PG8_LDA(At, 0, 1); PG8_STAGE(PG8_SA(0, 0), a2, voffA);
            PG8_BAR; PG8_WAIT_L(0); PG8_MMA(1, 0, At, B0); PG8_BAR; PG8_SCHED;
            PG8_STAGE(PG8_SB(0, 1), b2 + hstep, voffB);
            PG8_WAIT_V(6); PG8_BAR; PG8_MMA(1, 1, At, B1); PG8_BAR;
            PG8_LDB(B0, 1, 0); PG8_SCHED; PG8_LDA(At, 1, 0); PG8_STAGE(PG8_SA(0, 1), a2 + hstep, voffA);
            PG8_WAIT_L(8); PG8_BAR; PG8_WAIT_L(0); PG8_MMA(0, 0, At, B0); PG8_BAR; PG8_SCHED;
            PG8_LDB(B1, 1, 1); PG8_STAGE(PG8_SB(1, 0), b3, voffB);
            PG8_BAR; PG8_WAIT_L(0); PG8_MMA(0, 1, At, B1); PG8_BAR;
            PG8_LDA(At, 1, 1); PG8_STAGE(PG8_SA(1, 0), a3, voffA);
            PG8_BAR; PG8_WAIT_L(0); PG8_MMA(1, 0, At, B0); PG8_BAR; PG8_SCHED;
            PG8_STAGE(PG8_SB(1, 1), b3 + hstep, voffB);
            PG8_WAIT_V(6); PG8_BAR; PG8_MMA(1, 1, At, B1); PG8_BAR;
            }
        }
        if constexpr (ALIGN_EPI) { if (wr == 0) PG8_BAR; }
        if constexpr (!Epi::AFTER_DRAIN) { E(acc, cur, wr, wc, fr, fq); S.done(cur); }
        if (!has_next) break;
#pragma unroll
        for (int a = 0; a < 2; ++a)
#pragma unroll
            for (int b = 0; b < 2; ++b)
#pragma unroll
                for (int m = 0; m < 4; ++m)
#pragma unroll
                    for (int n = 0; n < 2; ++n) acc[a][b][m][n] = (f32x4){0.f, 0.f, 0.f, 0.f};
        cur = nxt; cA = nA; cB = nB; ++ui;
        if constexpr (ALIGN_EPI) { if (wr == 1) PG8_BAR; }
    }
    PG8_WAIT_V(0);
    if constexpr (!ALIGN_EPI) { if (wr == 0) PG8_BAR; }
    PG8_BAR;
    if constexpr (Epi::AFTER_DRAIN) { E.fused(acc, cur, wr, wc, fr, fq, lds, wid, lane); S.done(cur); }
#undef PG8_SA
#undef PG8_SB
#undef PG8_STAGE
#undef PG8_LDA
#undef PG8_LDB
#undef PG8_MMA
#undef PG8_WAIT_V
#undef PG8_WAIT_L
#undef PG8_BAR
#undef PG8_SCHED
}
}
namespace att {
#define ATT_LAS __attribute__((address_space(3)))
typedef short bf16x8 __attribute__((ext_vector_type(8)));
typedef short s16x4 __attribute__((ext_vector_type(4)));
typedef float f32x16 __attribute__((ext_vector_type(16)));
typedef unsigned u32x4 __attribute__((ext_vector_type(4)));
typedef unsigned u32x2 __attribute__((ext_vector_type(2)));
typedef unsigned short bf16_t;
constexpr int NKEY = 384;
constexpr int KCH = NKEY * 16 + 16;
constexpr int VH = NKEY * 64 + 64;
constexpr int OROW = 144, OST_W = 32 * OROW;
constexpr int LDS_K = 0, LDS_V = 8 * KCH, LDS_O = LDS_V + 2 * VH, LDS_BYTES = LDS_O + 8 * OST_W;
struct Tensors { const bf16_t* proj; bf16_t* oall; float* lse; const float* sinks; };
struct Unit { int kind, b, h, blk; };
__device__ __forceinline__ int crow(int r, int lh) { return (r & 3) + 8 * (r >> 2) + 4 * lh; }
__device__ __forceinline__ unsigned cvtpk(float lo, float hi) { unsigned r; asm("v_cvt_pk_bf16_f32 %0, %1, %2" : "=v"(r) : "v"(lo), "v"(hi)); return r; }
__device__ __forceinline__ s16x4 vtr(const ATT_LAS unsigned char* p) { typedef short v4i16_t __attribute__((ext_vector_type(4)));
    return __builtin_bit_cast(s16x4, __builtin_amdgcn_ds_read_tr16_b64_v4i16((ATT_LAS v4i16_t*)p)); }

struct Geom { int dil, res, n, qcol, kcol, vcol, ocol, maxs; size_t rowbase; };
__device__ __forceinline__ Geom geom(const Unit& u) {
    Geom g; const int k = u.kind;
    g.dil = (k <= 1) ? 1 : (k == 2 ? 4 : 16);
    const int nper = 32 / g.dil;
    g.res = u.blk / nper; g.n = u.blk % nper;
    g.qcol = (k == 0 ? QA_OFF : QB_OFF) + u.h * HD;
    g.kcol = (k == 0 ? KA_OFF + (u.h >> 3) * HD : KB_OFF + u.h * HD);
    g.vcol = (k == 0 ? VA_OFF + (u.h >> 3) * HD : VB_OFF + u.h * HD);
    g.ocol = k * 1024 + u.h * HD;
    g.maxs = (k == 0) ? 127 : 128;
    g.rowbase = (size_t)u.b * SEQ;
    return g;
}
constexpr int NUNITS_A = BATCH * 2 * 32, NUNITS_B = BATCH * NH * 3 * 32;
__device__ __forceinline__ bool next_unit(int i, int vcu, int G, Unit& u) {
    int kind, bh, h8, blk; bool ok;
    if (G == 256) {
        ok = i < 25; const int j = i - 1;
        kind = (i == 0) ? 0 : 1 + j % 3; blk = vcu & 31;
        bh = (i == 0) ? (vcu >> 6) * 16 : (vcu >> 5) * 8 + j / 3;
        h8 = ((vcu >> 5) & 1) * 8;
    } else {
        const int id = i * G + vcu; ok = id < NUNITS_A + NUNITS_B; const int j = id - NUNITS_A;
        kind = (id < NUNITS_A) ? 0 : 1 + (j >> 5) % 3; blk = (id < NUNITS_A) ? (id & 31) : (j & 31);
        bh = (id < NUNITS_A) ? (id >> 6) * 16 : j / 96;
        h8 = ((id >> 5) & 1) * 8;
    }
    u.kind = kind; u.b = bh >> 4; u.h = (kind == 0) ? h8 : (bh & 15); u.blk = blk;
    return ok;
}
struct Stage { u32x4 k[6], v[6]; bf16x8 q[4]; };
__device__ __forceinline__ void q_load(bf16x8 (&q)[4], const Tensors& T, const Geom& g, int qcol, int tid) {
    const int wave = tid >> 6, lane = tid & 63, qi = lane & 31, lh = lane >> 5;
    const size_t qrow = g.rowbase + (size_t)(256 * g.n + 32 * wave + qi) * g.dil + g.res;
#pragma unroll
    for (int s = 0; s < 4; ++s) q[s] = *(const bf16x8*)(T.proj + qrow * DIN + qcol + 16 * s + 8 * lh);
}
__device__ __forceinline__ void stage_load(Stage& s, const Tensors& T, const Unit& u, int tid) {
    const Geom g = geom(u);
    q_load(s.q, T, g, g.qcol, tid);
#pragma unroll
    for (int i = 0; i < 6; ++i) {
        const int cid = tid + 512 * i, j = cid >> 3, c = cid & 7;
        const int lk = 256 * g.n - 128 + j;
        if (lk >= 0) { const size_t row = g.rowbase + (size_t)lk * g.dil + g.res; const bf16_t* p = T.proj + row * DIN + c * 8;
            s.k[i] = *(const u32x4*)(p + g.kcol); s.v[i] = *(const u32x4*)(p + g.vcol); }
        else { s.k[i] = (u32x4){0u, 0u, 0u, 0u}; s.v[i] = (u32x4){0u, 0u, 0u, 0u}; }
    }
}
__device__ __forceinline__ void stage_write(const Stage& s, ATT_LAS unsigned char* lds, int tid) {
#pragma unroll
    for (int i = 0; i < 6; ++i) {
        const int cid = tid + 512 * i, j = cid >> 3, c = cid & 7;
        *(ATT_LAS u32x4*)(lds + LDS_K + c * KCH + j * 16) = s.k[i];
        *(ATT_LAS u32x4*)(lds + LDS_V + (c >> 2) * VH + j * 64 + (c & 3) * 16) = s.v[i];
    }
}
__device__ __forceinline__ void k_load(bf16x8 (&kf)[4], const ATT_LAS unsigned char* lds, int jt, int qi, int lh) {
    const ATT_LAS unsigned char* kp = lds + LDS_K + lh * KCH + (jt + qi) * 16;
#pragma unroll
    for (int s = 0; s < 4; ++s) kf[s] = *(const ATT_LAS bf16x8*)(kp + 2 * s * KCH);
}
constexpr float THR = 6.0f;
template <bool FIRST_OR_LAST, bool PREFETCH>
__device__ __forceinline__ void tile_step(const ATT_LAS unsigned char* lds, int jt, int t, const bf16x8 (&qf)[4], bf16x8 (&kf)[4], float sl2, int maxs, bool force,
                                          int qi, int lh, int lane, float& m, float& lpart, f32x16 (&o)[2]) {
    const float tb = -sl2 * (float)(128 - 32 * t + qi - 4 * lh) - m;
    f32x16 p;
#pragma unroll
    for (int r = 0; r < 16; ++r) p[r] = fmaf(sl2, (float)((r & 3) + 8 * (r >> 2)), tb);
#pragma unroll
    for (int s = 0; s < 4; ++s) p = __builtin_amdgcn_mfma_f32_32x32x16_bf16(kf[s], qf[s], p, 0, 0, 0);
    const ATT_LAS unsigned char* vp = lds + LDS_V + (jt + 4 * lh + ((lane & 15) >> 2)) * 64 + ((lane >> 4) & 1) * 32 + (lane & 3) * 8;
    s16x4 vlo[2][2], vhi[2][2];
#pragma unroll
    for (int s = 0; s < 2; ++s) { vlo[0][s] = vtr(vp + s * 1024); vhi[0][s] = vtr(vp + s * 1024 + 512); }
    __builtin_amdgcn_sched_barrier(0);
    if (FIRST_OR_LAST) {
        const int sb = 128 - 32 * t + qi;
#pragma unroll
        for (int r = 0; r < 16; ++r) { const int st = sb - crow(r, lh); if (st < 0 || st > maxs) p[r] = -1e30f; }
    }
    float mx = p[0];
#pragma unroll
    for (int r = 1; r < 16; ++r) mx = fmaxf(mx, p[r]);
    { auto rr = __builtin_amdgcn_permlane32_swap(__float_as_uint(mx), __float_as_uint(mx), false, false); mx = fmaxf(__uint_as_float(rr[0]), __uint_as_float(rr[1])); }
    if (force || __any(mx > THR)) {
        const float dl = force ? mx : fmaxf(mx, 0.f); const float al = __builtin_amdgcn_exp2f(-dl);
        m += dl; lpart *= al;
#pragma unroll
        for (int r = 0; r < 16; ++r) { p[r] -= dl; o[0][r] *= al; o[1][r] *= al; }
    }
    float rs = 0.f;
#pragma unroll
    for (int r = 0; r < 16; ++r) { p[r] = __builtin_amdgcn_exp2f(p[r]); rs += p[r]; }
    lpart += rs;
    bf16x8 pb[2];
#pragma unroll
    for (int s = 0; s < 2; ++s) { u32x4 w; w.x = cvtpk(p[8 * s + 0], p[8 * s + 1]); w.y = cvtpk(p[8 * s + 2], p[8 * s + 3]); w.z = cvtpk(p[8 * s + 4], p[8 * s + 5]); w.w = cvtpk(p[8 * s + 6], p[8 * s + 7]);
        pb[s] = __builtin_bit_cast(bf16x8, w); }
    __builtin_amdgcn_sched_barrier(0);
#pragma unroll
    for (int s = 0; s < 2; ++s) { vlo[1][s] = vtr(vp + VH + s * 1024); vhi[1][s] = vtr(vp + VH + s * 1024 + 512); }
    if (PREFETCH) k_load(kf, lds, jt - 32, qi, lh);
    __builtin_amdgcn_sched_barrier(0);
#pragma unroll
    for (int d0 = 0; d0 < 2; ++d0)
#pragma unroll
        for (int s = 0; s < 2; ++s) { const s16x4 lo = vlo[d0][s], hi = vhi[d0][s];
            const bf16x8 vf = (bf16x8){lo[0], lo[1], lo[2], lo[3], hi[0], hi[1], hi[2], hi[3]};
            o[d0] = __builtin_amdgcn_mfma_f32_32x32x16_bf16(vf, pb[s], o[d0], 0, 0, 0); }
}
__device__ __forceinline__ void head_compute(const ATT_LAS unsigned char* lds_c, const Tensors& T, const Unit& u, const Geom& g, int h, int hh, const bf16x8 (&qf)[4], int wave, int lane) {
    const ATT_LAS unsigned char* lds = lds_c;
    const int qi = lane & 31, lh = lane >> 5;
    const int lq = 256 * g.n + 32 * wave + qi;
    const size_t qrow = g.rowbase + (size_t)lq * g.dil + g.res;
    const int kb0 = 256 * g.n - 128 + 32 * wave;
    const float slope = exp2f(-0.5f * (float)(h + 1));
    const float sl2 = slope * LOG2E * (float)g.dil;
    float m, lpart;
    if (u.kind == 0) { m = T.sinks[h] * LOG2E; lpart = (lh == 0) ? 1.f : 0.f; }
    else { m = 0.f; lpart = 0.f; }
    const bool force0 = (u.kind != 0);
    f32x16 o[2];
#pragma unroll
    for (int r = 0; r < 16; ++r) { o[0][r] = 0.f; o[1][r] = 0.f; }
    bf16x8 kf[4];
    k_load(kf, lds, 32 * (wave + 4), qi, lh);
    tile_step<true, true>(lds, 32 * (wave + 4), 4, qf, kf, sl2, g.maxs, force0, qi, lh, lane, m, lpart, o);
    if (kb0 + 96 >= 0) tile_step<false, true>(lds, 32 * (wave + 3), 3, qf, kf, sl2, g.maxs, false, qi, lh, lane, m, lpart, o);
    if (kb0 + 64 >= 0) tile_step<false, true>(lds, 32 * (wave + 2), 2, qf, kf, sl2, g.maxs, false, qi, lh, lane, m, lpart, o);
    if (kb0 + 32 >= 0) tile_step<false, true>(lds, 32 * (wave + 1), 1, qf, kf, sl2, g.maxs, false, qi, lh, lane, m, lpart, o);
    if (kb0 >= 0)      tile_step<true, false>(lds, 32 * wave, 0, qf, kf, sl2, g.maxs, false, qi, lh, lane, m, lpart, o);
    float l;
    { auto rr = __builtin_amdgcn_permlane32_swap(__float_as_uint(lpart), __float_as_uint(lpart), false, false); l = __uint_as_float(rr[0]) + __uint_as_float(rr[1]); }
    const float inv = 1.0f / l;
    if (u.kind != 0 && lh == 0) T.lse[((size_t)(u.kind - 1) * MROWS + qrow) * NH + h] = m + log2f(l);
    ATT_LAS unsigned char* ost = (ATT_LAS unsigned char*)lds + LDS_O + wave * OST_W;
#pragma unroll
    for (int d0 = 0; d0 < 2; ++d0)
#pragma unroll
        for (int q4 = 0; q4 < 4; ++q4) { u32x2 w; w.x = cvtpk(o[d0][4 * q4 + 0] * inv, o[d0][4 * q4 + 1] * inv); w.y = cvtpk(o[d0][4 * q4 + 2] * inv, o[d0][4 * q4 + 3] * inv);
            *(ATT_LAS u32x2*)(ost + qi * OROW + (32 * d0 + 8 * q4 + 4 * lh) * 2) = w; }
    asm volatile("s_waitcnt lgkmcnt(0)" ::: "memory");
    const size_t row0 = g.rowbase + (size_t)(256 * g.n + 32 * wave) * g.dil + g.res;
#pragma unroll
    for (int i = 0; i < 4; ++i) { const int j = i * 8 + (lane >> 3), ch = lane & 7;
        const u32x4 v = *(const ATT_LAS u32x4*)(ost + j * OROW + ch * 16);
        *(u32x4*)(T.oall + (row0 + (size_t)j * g.dil) * 4096 + g.ocol + hh * HD + ch * 8) = v; }
    asm volatile("s_waitcnt lgkmcnt(0)" ::: "memory");
}
__device__ __forceinline__ void phase(ATT_LAS unsigned char* lds, const Tensors& T, int vcu, int G, int tid, int wave, int lane) {
    Unit cur, nxt; Stage st;
    if (!next_unit(0, vcu, G, cur)) return;
    stage_load(st, T, cur, tid);
    for (int i = 0;; ++i) {
        { int tz = tid; asm volatile("" : "+v"(tz)); tid = tz; lane = tz & 63; }
        __syncthreads();
        stage_write(st, lds, tid);
        bf16x8 qf[4] = {st.q[0], st.q[1], st.q[2], st.q[3]};
        __syncthreads();
        const bool has_next = next_unit(i + 1, vcu, G, nxt);
        const Geom g = geom(cur);
        if (cur.kind != 0) {
            if (has_next) stage_load(st, T, nxt, tid);
            head_compute(lds, T, cur, g, cur.h, 0, qf, wave, lane);
        } else {
            for (int hh = 0; hh < 8; ++hh) {
                if (hh < 7) q_load(st.q, T, g, g.qcol + (hh + 1) * HD, tid);
                head_compute(lds, T, cur, g, cur.h + hh, hh, qf, wave, lane);
#pragma unroll
                for (int s = 0; s < 4; ++s) qf[s] = st.q[s];
            }
            if (has_next) stage_load(st, T, nxt, tid);
        }
        if (!has_next) break;
        cur = nxt;
    }
    __syncthreads();
}
#undef ATT_LAS
}


constexpr int NWAVES = 8;
constexpr int N_LAUNCHES = MK_N_LAUNCHES;
constexpr int N_PHASES = 8;
constexpr size_t MiB = 1u << 20;
constexpr size_t WS_CTL = 0, CTL_ZERO_BYTES = 1 * MiB;
constexpr size_t WS_WIN = 2 * MiB;
constexpr size_t WS_WOUT = 19 * MiB;
constexpr size_t WS_W1 = 27 * MiB;
constexpr size_t WS_W2 = 59 * MiB;
constexpr size_t WS_LSE = 91 * MiB;
constexpr size_t WS_XN = 97 * MiB;
constexpr size_t WS_PROJ = 225 * MiB;
constexpr size_t WS_OALL = 497 * MiB;
constexpr size_t WS_U = 225 * MiB;
constexpr size_t WS_X1B = 753 * MiB;
constexpr size_t WS_END = 881 * MiB;
static_assert(WS_WIN + (size_t)DIN * DM * 2 <= WS_WOUT && WS_WOUT + (size_t)DM * DM * 2 <= WS_W1 && WS_W1 + (size_t)FF * DM * 2 <= WS_W2 && WS_W2 + (size_t)DM * FF * 2 <= WS_LSE, "weights map");
static_assert(WS_LSE + (size_t)3 * MROWS * 16 * 4 <= WS_XN && WS_XN + (size_t)MROWS * DM * 2 <= WS_PROJ && WS_PROJ + (size_t)MROWS * DIN * 2 <= WS_OALL && WS_OALL + (size_t)MROWS * 4096 * 2 <= WS_X1B && WS_X1B + (size_t)MROWS * DM * 2 <= WS_END, "activation map");
static_assert(WS_U >= WS_XN + (size_t)MROWS * DM * 2 && WS_U + (size_t)MROWS * FF * 2 <= WS_X1B, "u overlay");
constexpr int CW_BAR = 4096;
constexpr int CW_SSQ = 65536;
constexpr int RING_OFF = 0, RING_BYTES = 131072;
constexpr int LDS_BYTES = 147456;
constexpr int LDSCTL_OFF = LDS_BYTES - 512, MISC_OFF = LDSCTL_OFF + 320;
static_assert((size_t)(CW_SSQ + MROWS) * 4 <= CTL_ZERO_BYTES, "ssq inside the memset region");
static_assert(att::LDS_BYTES <= LDSCTL_OFF && RING_BYTES <= LDSCTL_OFF && MISC_OFF + 128 <= LDS_BYTES, "LDS map");

#define GAS __attribute__((address_space(1)))
#define LAS __attribute__((address_space(3)))
typedef unsigned short bf16;
typedef unsigned v4u __attribute__((ext_vector_type(4)));
typedef float f32x4 __attribute__((ext_vector_type(4)));
typedef short bf16x8 __attribute__((ext_vector_type(8)));
typedef GAS unsigned gu32;
typedef GAS unsigned long long gu64;
#define RLX_AGENT __ATOMIC_RELAXED, __HIP_MEMORY_SCOPE_AGENT
#define LDS_WAIT() asm volatile("s_waitcnt lgkmcnt(0)" ::: "memory")
#define VM_WAIT() asm volatile("s_waitcnt vmcnt(0)" ::: "memory")
__device__ __forceinline__ unsigned long long rt() { return __builtin_amdgcn_s_memrealtime(); }
__device__ __forceinline__ unsigned f2bf(float f) { unsigned u = __builtin_bit_cast(unsigned, f); return (u + 0x7fffu + ((u >> 16) & 1u)) >> 16; }
__device__ __forceinline__ unsigned pk2(float lo, float hi) { return f2bf(lo) | (f2bf(hi) << 16); }

#define XB_TMO      128
#define XB_XCNT(j)  (256  + 64 * (j))
#define XB_XSUB(j)  (1280 + 64 * (j))
#define XB_XGEN(j)  (2304 + 64 * (j))
#define XB_TOP      3328
#define XB_TOPGEN   3392
#define XCD_BAR_WORDS 3456
#define XB_SPIN_CAP (1u << 18)

__device__ __forceinline__ unsigned xb_ld(unsigned* p)              { return __hip_atomic_load(p, __ATOMIC_RELAXED, __HIP_MEMORY_SCOPE_AGENT); }
__device__ __forceinline__ unsigned xb_add(unsigned* p, unsigned v) { return __hip_atomic_fetch_add(p, v, __ATOMIC_RELAXED, __HIP_MEMORY_SCOPE_AGENT); }
__device__ __forceinline__ unsigned xb_xcc_id() { return (unsigned)__builtin_amdgcn_s_getreg((3 << 11) | 20) & 0xFu; }
#define XB_SPIN(cond, bar) do { unsigned _sp = 0; while (cond) { __builtin_amdgcn_s_sleep(1); \
    if ((++_sp & 255u) == 0u) { if (xb_ld(&(bar)[XB_TMO])) break; if (_sp > XB_SPIN_CAP) { atomicAdd(&(bar)[XB_TMO], 1u); break; } } } } while (0)

struct XcdBarrier {
    unsigned* bar; unsigned x;
    volatile LAS unsigned* st;
};

__device__ __forceinline__ XcdBarrier xcd_barrier_post(unsigned* bar, volatile LAS unsigned* st) {
    XcdBarrier b; b.bar = bar; b.x = xb_xcc_id(); b.st = st;
    if (threadIdx.x == 0) (void)xb_add(&bar[XB_XCNT(b.x)], 1u);
    return b;
}
__device__ __forceinline__ void xcd_barrier_complete(unsigned* bar, unsigned x, unsigned& nloc, unsigned& nx) {
    const unsigned G = gridDim.x * gridDim.y * gridDim.z;
    unsigned sum, cnt, mine, sp = 0u;
    for (;;) {
        sum = 0u; cnt = 0u; mine = 0u;
#pragma unroll
        for (unsigned j = 0; j < 16; ++j) { const unsigned c = xb_ld(&bar[XB_XCNT(j)]); sum += c; cnt += (c > 0u) ? 1u : 0u; mine = (j == x) ? c : mine; }
        if (sum == G) break;
        __builtin_amdgcn_s_sleep(1);
        if ((++sp & 255u) == 0u) { if (xb_ld(&bar[XB_TMO])) break; if (sp > XB_SPIN_CAP) { atomicAdd(&bar[XB_TMO], 1u); break; } }
    }
    nloc = mine > 0u ? mine : 1u; nx = cnt > 0u ? cnt : 1u;
}

__device__ __forceinline__ void xcd_barrier(const XcdBarrier& b) {
    asm volatile("s_waitcnt vmcnt(0)" ::: "memory");
    __syncthreads();
    if (threadIdx.x == 0) {
        unsigned* bar = b.bar;
        __builtin_amdgcn_s_waitcnt(0);
        unsigned nloc = b.st[0], nx = b.st[1];
        if (nloc == 0u) { xcd_barrier_complete(bar, b.x, nloc, nx); b.st[0] = nloc; b.st[1] = nx; }
        const unsigned old = xb_add(&bar[XB_XSUB(b.x)], 1u);
        const unsigned gen = old / nloc;
        if (old + 1u == (gen + 1u) * nloc) {
            __builtin_amdgcn_fence(__ATOMIC_RELEASE, "agent");
            asm volatile("s_waitcnt vmcnt(0)" ::: "memory");
            const unsigned og = xb_add(&bar[XB_TOP], 1u);
            const unsigned tg = og / nx;
            if (og + 1u == (tg + 1u) * nx) xb_add(&bar[XB_TOPGEN], 1u);
            else XB_SPIN(xb_ld(&bar[XB_TOPGEN]) == tg, bar);
            __builtin_amdgcn_fence(__ATOMIC_ACQUIRE, "agent");
            xb_add(&bar[XB_XGEN(b.x)], 1u);
            asm volatile("s_waitcnt vmcnt(0)" ::: "memory");
        } else {
            XB_SPIN(xb_ld(&bar[XB_XGEN(b.x)]) == gen, bar);
            __builtin_amdgcn_fence(__ATOMIC_ACQUIRE, "agent");
            asm volatile("s_waitcnt vmcnt(0)" ::: "memory");
        }
    }
    __syncthreads();
}

__device__ __forceinline__ float wave_sum(float v) {
#pragma unroll
    for (int o = 1; o < 64; o <<= 1) v += __shfl_xor(v, o);
    return v;
}
__device__ __forceinline__ void p0_transpose_item(const float* W, int K, int N, bf16* WT, LAS float* scr, int item, int lane, const float* gain = nullptr) {
    const int nblk = N / 32, kb = item / nblk, nb = item % nblk, k0 = 64 * kb, n0 = 32 * nb;
    float wv[32];
#pragma unroll
    for (int i = 0; i < 32; ++i) { const int kk = 2 * i + (lane >> 5); wv[i] = W[(size_t)(k0 + kk) * N + n0 + (lane & 31)]; }
    if (gain) {
#pragma unroll
        for (int i = 0; i < 32; ++i) wv[i] *= gain[k0 + 2 * i + (lane >> 5)];
    }
#pragma unroll
    for (int i = 0; i < 32; ++i) { const int kk = 2 * i + (lane >> 5); scr[kk * 33 + (lane & 31)] = wv[i]; }
    LDS_WAIT(); asm volatile("" ::: "memory");
    const int c = lane & 7;
#pragma unroll
    for (int j = 0; j < 4; ++j) { const int n = (lane >> 3) + 8 * j; const LAS float* s = scr + (8 * c) * 33 + n;
        v4u o; o.x = pk2(s[0 * 33], s[1 * 33]); o.y = pk2(s[2 * 33], s[3 * 33]); o.z = pk2(s[4 * 33], s[5 * 33]); o.w = pk2(s[6 * 33], s[7 * 33]);
        *(GAS v4u*)(WT + (size_t)(n0 + n) * K + k0 + 8 * c) = o; }
    LDS_WAIT(); asm volatile("" ::: "memory");
}
__device__ __forceinline__ void rms_row_to_bf16(const float* xrow, const float* g, bf16* orow, int lane) {
    const GAS f32x4* xr = (const GAS f32x4*)xrow + lane; const GAS f32x4* gr = (const GAS f32x4*)g + lane;
    f32x4 v[8]; float s = 0.f;
#pragma unroll
    for (int j = 0; j < 8; ++j) { v[j] = xr[64 * j]; s += (v[j].x * v[j].x + v[j].y * v[j].y) + (v[j].z * v[j].z + v[j].w * v[j].w); }
    const float rstd = 1.0f / sqrtf(wave_sum(s) * (1.f / DM) + RMS_EPS);
    GAS unsigned long long* o8 = (GAS unsigned long long*)orow + lane;
#pragma unroll
    for (int j = 0; j < 8; ++j) { const f32x4 gg = gr[64 * j]; const f32x4 y = (v[j] * rstd) * gg;
        o8[64 * j] = (unsigned long long)pk2(y.x, y.y) | ((unsigned long long)pk2(y.z, y.w) << 32); }
}
__device__ __forceinline__ void rms_row_inplace(float* xrow, const float* g, int lane) {
    GAS f32x4* xr = (GAS f32x4*)xrow + lane; const GAS f32x4* gr = (const GAS f32x4*)g + lane;
    f32x4 v[8]; float s = 0.f;
#pragma unroll
    for (int j = 0; j < 8; ++j) { v[j] = xr[64 * j]; s += (v[j].x * v[j].x + v[j].y * v[j].y) + (v[j].z * v[j].z + v[j].w * v[j].w); }
    const float rstd = 1.0f / sqrtf(wave_sum(s) * (1.f / DM) + RMS_EPS);
#pragma unroll
    for (int j = 0; j < 8; ++j) { const f32x4 gg = gr[64 * j]; xr[64 * j] = (v[j] * rstd) * gg; }
}
__device__ __forceinline__ float bf_lo(unsigned w) { return __uint_as_float(w << 16); }
__device__ __forceinline__ float bf_hi(unsigned w) { return __uint_as_float(w & 0xffff0000u); }
__device__ __forceinline__ void combine_row(const bf16* orow  , const float* lse  , const float* ga, const float* gb, bf16* mrow  , int lane) {
    const GAS v4u* o4 = (const GAS v4u*)orow + 2 * lane;
    v4u ra[2], rb[3][2];
#pragma unroll
    for (int q = 0; q < 2; ++q) { ra[q] = o4[q]; rb[0][q] = o4[128 + q]; rb[1][q] = o4[256 + q]; rb[2][q] = o4[384 + q]; }
    const int head = lane >> 2;
    float l0 = lse[head], l1 = lse[(size_t)MROWS * 16 + head], l2 = lse[(size_t)2 * MROWS * 16 + head];
    const float lm = fmaxf(l0, fmaxf(l1, l2));
    float w0 = exp2f(l0 - lm), w1 = exp2f(l1 - lm), w2 = exp2f(l2 - lm);
    const float wi = 1.0f / (w0 + w1 + w2); w0 *= wi; w1 *= wi; w2 *= wi;
    float a[16], b[16]; float sa = 0.f, sb = 0.f;
#pragma unroll
    for (int q = 0; q < 2; ++q)
#pragma unroll
        for (int e = 0; e < 4; ++e) {
            const unsigned wa = ra[q][e], x0 = rb[0][q][e], x1 = rb[1][q][e], x2 = rb[2][q][e];
            const int i = q * 8 + e * 2;
            a[i] = bf_lo(wa); a[i + 1] = bf_hi(wa);
            b[i] = w0 * bf_lo(x0) + w1 * bf_lo(x1) + w2 * bf_lo(x2);
            b[i + 1] = w0 * bf_hi(x0) + w1 * bf_hi(x1) + w2 * bf_hi(x2);
            sa += a[i] * a[i] + a[i + 1] * a[i + 1]; sb += b[i] * b[i] + b[i + 1] * b[i + 1];
        }
    const float ra_ = 1.0f / sqrtf(wave_sum(sa) * (1.f / 1024.f) + RMS_EPS), rb_ = 1.0f / sqrtf(wave_sum(sb) * (1.f / 1024.f) + RMS_EPS);
    const GAS f32x4* ga4 = (const GAS f32x4*)ga + 4 * lane; const GAS f32x4* gb4 = (const GAS f32x4*)gb + 4 * lane;
    GAS v4u* m4 = (GAS v4u*)mrow + 2 * lane;
#pragma unroll
    for (int q = 0; q < 2; ++q) {
        const f32x4 g0 = ga4[2 * q], g1 = ga4[2 * q + 1], h0 = gb4[2 * q], h1 = gb4[2 * q + 1];
        v4u wa, wb; const int i = q * 8;
        wa.x = pk2(a[i + 0] * ra_ * g0.x, a[i + 1] * ra_ * g0.y); wa.y = pk2(a[i + 2] * ra_ * g0.z, a[i + 3] * ra_ * g0.w);
        wa.z = pk2(a[i + 4] * ra_ * g1.x, a[i + 5] * ra_ * g1.y); wa.w = pk2(a[i + 6] * ra_ * g1.z, a[i + 7] * ra_ * g1.w);
        wb.x = pk2(b[i + 0] * rb_ * h0.x, b[i + 1] * rb_ * h0.y); wb.y = pk2(b[i + 2] * rb_ * h0.z, b[i + 3] * rb_ * h0.w);
        wb.z = pk2(b[i + 4] * rb_ * h1.x, b[i + 5] * rb_ * h1.y); wb.w = pk2(b[i + 6] * rb_ * h1.z, b[i + 7] * rb_ * h1.w);
        m4[q] = wa; m4[128 + q] = wb;
    }
}

struct Args { const float* in[12]; float* out; unsigned char* ws; int ph_lo, ph_hi; };
__global__ void __launch_bounds__(NWAVES * 64, 2) block_fwd(Args args) {
    extern __shared__ __attribute__((aligned(16))) unsigned char lds_raw[];
    LAS unsigned char* lds = (LAS unsigned char*)lds_raw;
    volatile LAS unsigned* MISC = (volatile LAS unsigned*)(lds + MISC_OFF);
    const int tid = threadIdx.x, lane = tid & 63, wave = __builtin_amdgcn_readfirstlane(tid >> 6);
    const int G = gridDim.x; const int bx = blockIdx.x;
    const int vcu = (G % 8 == 0) ? (bx % 8) * (G / 8) + bx / 8 : bx;
    unsigned char* ws = args.ws;
    gu32* ctl = (gu32*)(ws + WS_CTL);
    const float* x = args.in[0]; const float* g_attn = args.in[1]; const float* w_in = args.in[2]; const float* b_in = args.in[3]; const float* sinks = args.in[4];
    const float* g_out_a = args.in[5]; const float* g_out_b = args.in[6]; const float* w_out = args.in[7]; const float* g_mlp = args.in[8];
    const float* w_1 = args.in[9]; const float* w_2 = args.in[10]; const float* g_final = args.in[11];
    float* out = args.out;
    bf16* Win_t = (bf16*)(ws + WS_WIN); bf16* Wout_t = (bf16*)(ws + WS_WOUT); bf16* W1_t = (bf16*)(ws + WS_W1); bf16* W2_t = (bf16*)(ws + WS_W2);
    float* LSE = (float*)(ws + WS_LSE); bf16* XN = (bf16*)(ws + WS_XN); bf16* PROJ = (bf16*)(ws + WS_PROJ); bf16* OALL = (bf16*)(ws + WS_OALL); bf16* U = (bf16*)(ws + WS_U); bf16* X1B = (bf16*)(ws + WS_X1B); float* SSQ = (float*)(ctl + CW_SSQ);

    for (int u = tid; u < (LDS_BYTES - LDSCTL_OFF) / 4; u += NWAVES * 64) ((LAS unsigned*)(lds + LDSCTL_OFF))[u] = 0u;
    __syncthreads();
    XcdBarrier bar; bar.bar = (unsigned*)(ctl + CW_BAR); bar.x = 0; bar.st = nullptr;
    if (N_LAUNCHES == 1) bar = xcd_barrier_post((unsigned*)(ctl + CW_BAR), MISC + 8);
    const int lo = args.ph_lo, hi = args.ph_hi;
#define IN(k) (lo <= (k) && (k) < hi)
#define GRID_BAR(k) do { if (IN(k) && IN((k) + 1)) xcd_barrier(bar); } while (0)
    const int gw = vcu * NWAVES + wave, NGW = G * NWAVES;

    constexpr int I_IN = (DM / 64) * (DIN / 32), I_OUT = (DM / 64) * (DM / 32), I_1 = (DM / 64) * (FF / 32), I_2 = (FF / 64) * (DM / 32);
    if (IN(0)) {
        LAS float* scr = (LAS float*)(lds + RING_OFF + wave * 16384);
        for (int it = gw; it < I_IN; it += NGW) p0_transpose_item(w_in, DM, DIN, Win_t, scr, it, lane);
        for (int m = gw; m < MROWS; m += NGW) rms_row_to_bf16(x + (size_t)m * DM, g_attn, XN + (size_t)m * DM, lane);
    }
    GRID_BAR(0);
    if (IN(1)) {
        pg8::Gemm g{XN, Win_t, MROWS, DIN, DM}; pg8::StaticOrder S; S.init(MROWS, DIN, G, bx);
        pg8::EpiProj E{PROJ, DIN, b_in, QSCALE};
        pg8::gemm_phase<pg8::EpiProj, pg8::StaticOrder, true, true>(lds + RING_OFF, g, S, E);
        { pg8::Unit ulast; const int nr = (MROWS / 256) * (DIN / 256) / G;
          const bool shortwg = !S.next(nr, ulast);
          int nshort = G - ((MROWS / 256) * (DIN / 256) - nr * G); if (nshort <= 0 || nshort > G) nshort = G;
          const bool all = (nshort == G);
          if (shortwg || all) {
            LAS float* scr = (LAS float*)(lds + RING_OFF + wave * 16384);
            const int rank = all ? bx : (bx - (G - nshort));
            const int nw2 = nshort * NWAVES;
            for (int it = rank * NWAVES + wave; it < I_OUT + I_1 + I_2; it += nw2) {
                int r = it;
                if (r < I_OUT) { p0_transpose_item(w_out, DM, DM, Wout_t, scr, r, lane); continue; } r -= I_OUT;
                if (r < I_1) { p0_transpose_item(w_1, DM, FF, W1_t, scr, r, lane, g_mlp); continue; } r -= I_1;
                p0_transpose_item(w_2, FF, DM, W2_t, scr, r, lane);
            }
          }
        }
    }
    GRID_BAR(1);
    if (IN(2)) {
        const att::Tensors T{PROJ, OALL, LSE, sinks};
        att::phase(lds + RING_OFF, T, vcu, G, tid, wave, lane);
    }
    GRID_BAR(2);
    if (IN(3)) {
        for (int m = gw; m < MROWS; m += NGW) combine_row(OALL + (size_t)m * 4096, LSE + (size_t)m * 16, g_out_a, g_out_b, XN + (size_t)m * DM, lane);
    }
    GRID_BAR(3);
    if (IN(4)) {
        pg8::Gemm g{XN, Wout_t, MROWS, DM, DM}; pg8::StaticOrder S; S.init(MROWS, DM, G, bx);
        pg8::EpiResF32Bf E{x, out, X1B, SSQ, DM};
        pg8::gemm_phase<pg8::EpiResF32Bf, pg8::StaticOrder, true, true>(lds + RING_OFF, g, S, E);
    }
    GRID_BAR(4);
    if (IN(5)) {
        pg8::Gemm g{X1B, W1_t, MROWS, FF, DM}; pg8::StaticOrder S; S.init(MROWS, FF, G, bx);
        pg8::EpiRelu2S E{U, FF, SSQ, 1.0f / DM, RMS_EPS};
        pg8::gemm_phase<pg8::EpiRelu2S, pg8::StaticOrder, true, true>(lds + RING_OFF, g, S, E);
    }
    GRID_BAR(5);
    if (IN(6)) {
        pg8::Gemm g{U, W2_t, MROWS, DM, FF}; pg8::StaticOrder S; S.init(MROWS, DM, G, bx); S.wgm = 4; S.rev = 1;
        pg8::EpiResF32 E{out, out, DM};
        pg8::gemm_phase<pg8::EpiResF32, pg8::StaticOrder, true, true>(lds + RING_OFF, g, S, E);
    }
    GRID_BAR(6);
    if (IN(7)) {
        for (int m = gw; m < MROWS; m += NGW) rms_row_inplace(out + (size_t)m * DM, g_final, lane);
    }
#undef IN
#undef GRID_BAR
}

extern "C" void kernel_launch(void* const* d_in, const int* in_sizes, int n_in, void* d_out, int out_size, void* d_ws, size_t ws_size, hipStream_t stream) {
    static int grid = 0;
    if (grid == 0) {
        if (n_in != 12 || in_sizes[0] != MROWS * DM || out_size != MROWS * DM || ws_size < WS_END) {
            fprintf(stderr, "kernel_launch: built for 12 inputs, x/out of %d floats, >= %zu bytes of workspace; got n_in %d, in0 %d, out %d, ws %zu; nothing launched\n", MROWS * DM, (size_t)WS_END, n_in, n_in > 0 ? in_sizes[0] : -1, out_size, ws_size); grid = -1; return; }
        int dev = 0, cus = 0, per_cu = 0;
        if (hipGetDevice(&dev) != hipSuccess || hipDeviceGetAttribute(&cus, hipDeviceAttributeMultiprocessorCount, dev) != hipSuccess) { fprintf(stderr, "kernel_launch: device query failed\n"); grid = -1; return; }
        if (hipFuncSetAttribute((const void*)block_fwd, hipFuncAttributeMaxDynamicSharedMemorySize, LDS_BYTES) != hipSuccess) { fprintf(stderr, "kernel_launch: hipFuncSetAttribute failed\n"); grid = -1; return; }
        if (hipOccupancyMaxActiveBlocksPerMultiprocessor(&per_cu, (const void*)block_fwd, NWAVES * 64, LDS_BYTES) != hipSuccess || per_cu < 1)
            fprintf(stderr, "kernel_launch: note: occupancy query reports %d workgroups per CU\n", per_cu);
        (void)hipGetLastError();
        grid = cus;
    }
    if (grid < 0) return;
    if (hipMemsetAsync((char*)d_ws + WS_CTL, 0, CTL_ZERO_BYTES, stream) != hipSuccess) { fprintf(stderr, "kernel_launch: memset failed\n"); return; }
    Args a{};
    for (int i = 0; i < 12; ++i) a.in[i] = (const float*)d_in[i];
    a.out = (float*)d_out; a.ws = (unsigned char*)d_ws;
    if (N_LAUNCHES == 1) { a.ph_lo = 0; a.ph_hi = N_PHASES; hipLaunchKernelGGL(block_fwd, dim3(grid), dim3(NWAVES * 64), LDS_BYTES, stream, a); }
    else for (int li = 0; li < N_PHASES; ++li) { a.ph_lo = li; a.ph_hi = li + 1; hipLaunchKernelGGL(block_fwd, dim3(grid), dim3(NWAVES * 64), LDS_BYTES, stream, a); }
    const hipError_t le = hipPeekAtLastError();
    if (le != hipSuccess) fprintf(stderr, "kernel_launch: launch failed: %s\n", hipGetErrorName(le));
}
```
